# Optimizing an MI355X kernel written in HIP

```python
import math
import jax
import jax.numpy as jnp
from jax import lax
import numpy as np

D_MODEL = 1024
BATCH = 2
SEQ = 8192
DEPTH = 2

ROPE_THETA = 10000.0
NORM_EPS = 1e-6
QBLK = 128
NEG = -1e30

A_HEADS = 6
A_HEAD_DIM = 64
A_CONFIGS = ((128, 1), (512, 4), (2048, 16))
B_HEADS = 6
B_NOPE = 64
B_ROPE = 32
B_V = 64
B_Q_LORA = 384
B_KV_LORA = 128
C_HEADS = 4
C_QK = 32
C_V = 2 * C_QK
C_SUBLN_EPS = 1e-5

A_WIDTH = A_HEADS * A_HEAD_DIM
B_WIDTH = B_HEADS * B_V
C_WIDTH = C_HEADS * C_V
MIX_WIDTH = A_WIDTH + B_WIDTH + C_WIDTH

IN_SPLITS = (A_WIDTH, A_WIDTH, A_WIDTH,
             B_Q_LORA, B_KV_LORA, B_ROPE,
             C_HEADS * 2 * C_QK, C_HEADS * 2 * C_QK, C_WIDTH)
IN_COLS = int(sum(IN_SPLITS))
D_FF = 4 * D_MODEL

kernel_name = "hybrid_dilated_mla_diffattn_block"


def rmsnorm(x, g, eps=NORM_EPS):
    xf = x.astype(jnp.float32)
    y = xf * lax.rsqrt(jnp.mean(xf * xf, axis=-1, keepdims=True) + eps)
    return (y * g.astype(jnp.float32)).astype(x.dtype)


def rope_tables(seq, dim):
    half = dim // 2
    inv = 1.0 / (ROPE_THETA ** (jnp.arange(half, dtype=jnp.float32) / half))
    ang = jnp.arange(seq, dtype=jnp.float32)[:, None] * inv[None, :]
    return jnp.cos(ang), jnp.sin(ang)


def apply_rope(x, cos, sin):
    half = x.shape[-1] // 2
    xf = x.astype(jnp.float32)
    x1, x2 = xf[..., :half], xf[..., half:]
    return jnp.concatenate([x1 * cos - x2 * sin, x1 * sin + x2 * cos], axis=-1).astype(x.dtype)


def to_heads(t, n_heads):
    b, s, _ = t.shape
    return t.reshape(b, s, n_heads, -1).transpose(0, 2, 1, 3)


def from_heads(t):
    b, h, s, d = t.shape
    return t.transpose(0, 2, 1, 3).reshape(b, s, h * d)


def banded_attn(q, k, v, span, scale):
    b, g, n, dh = q.shape
    nb = n // span
    qb = q.reshape(b, g, nb, span, dh)
    kb = k.reshape(b, g, nb, span, dh)
    vb = v.reshape(b, g, nb, span, v.shape[-1])

    def with_prev(t):
        prev = jnp.pad(t[:, :, :-1], ((0, 0), (0, 0), (1, 0), (0, 0), (0, 0)))
        return jnp.concatenate([prev, t], axis=3)

    kk, vv = with_prev(kb), with_prev(vb)
    s = jnp.einsum('bgnqd,bgnkd->bgnqk', qb, kk).astype(jnp.float32) * scale
    qi = jnp.arange(span)[:, None]
    ki = jnp.arange(2 * span)[None, :]
    dist = qi + span - ki
    blk = jnp.arange(nb)[:, None, None]
    valid = (dist >= 0) & (dist <= span) & ((blk > 0) | (ki >= span))
    s = jnp.where(valid, s, NEG)
    lse = jax.nn.logsumexp(s, axis=-1)
    p = jnp.exp(s - lse[..., None])
    out = jnp.einsum('bgnqk,bgnkd->bgnqd', p.astype(v.dtype), vv)
    return out.reshape(b, g, n, -1), lse.reshape(b, g, n)


def dilated_attn(q, k, v, window, dilation, scale):
    b, h, s, dh = q.shape
    span = window // dilation
    unit = dilation * span
    sp = -(-s // unit) * unit
    sub = sp // dilation

    def split(t):
        t = jnp.pad(t, ((0, 0), (0, 0), (0, sp - s), (0, 0)))
        return t.reshape(b, h, sub, dilation, t.shape[-1]).transpose(0, 1, 3, 2, 4).reshape(b, h * dilation, sub, t.shape[-1])

    out, lse = banded_attn(split(q), split(k), split(v), span, scale)
    out = out.reshape(b, h, dilation, sub, -1).transpose(0, 1, 3, 2, 4).reshape(b, h, sp, -1)[:, :, :s]
    lse = lse.reshape(b, h, dilation, sub).transpose(0, 1, 3, 2).reshape(b, h, sp)[:, :, :s]
    return out, lse


def causal_attn(q, k, v, scale, coef):
    b, h, m, s, dq = q.shape
    nb = s // QBLK
    qb = q.reshape(b, h, m, nb, QBLK, dq).transpose(3, 0, 1, 2, 4, 5)
    kpos = jnp.arange(s)

    def one(args):
        qblk, i = args
        sc = jnp.einsum('bhmqd,bhmkd->bhmqk', qblk, k).astype(jnp.float32) * scale
        qpos = i * QBLK + jnp.arange(QBLK)
        sc = jnp.where(kpos[None, :] <= qpos[:, None], sc, NEG)
        p = jnp.einsum('bhmqk,m->bhqk', jax.nn.softmax(sc, axis=-1), coef)
        return jnp.einsum('bhqk,bhkd->bhqd', p.astype(v.dtype), v)

    out = lax.map(one, (qb, jnp.arange(nb)))
    return out.transpose(1, 2, 0, 3, 4).reshape(b, h, s, -1)


def mixer_dilated(qa, ka, va, cos64, sin64):
    q = apply_rope(to_heads(qa, A_HEADS), cos64, sin64)
    k = apply_rope(to_heads(ka, A_HEADS), cos64, sin64)
    v = to_heads(va, A_HEADS)
    scale = A_HEAD_DIM ** -0.5
    outs, lses = [], []
    for window, dilation in A_CONFIGS:
        o, l = dilated_attn(q, k, v, window, dilation, scale)
        outs.append(o)
        lses.append(l)
    w = jax.nn.softmax(jnp.stack(lses, axis=0), axis=0)
    out = jnp.sum(w[..., None].astype(v.dtype) * jnp.stack(outs, axis=0), axis=0)
    return from_heads(out)


def mixer_mla(cq, ckv, kr, q_norm_g, w_uq, kv_norm_g, w_ukv, cos32, sin32):
    b, s, _ = cq.shape
    qf = to_heads(rmsnorm(cq, q_norm_g) @ w_uq, B_HEADS)
    kvf = to_heads(rmsnorm(ckv, kv_norm_g) @ w_ukv, B_HEADS)
    q = jnp.concatenate([qf[..., :B_NOPE], apply_rope(qf[..., B_NOPE:], cos32, sin32)], axis=-1)
    k_rope = jnp.broadcast_to(apply_rope(kr, cos32, sin32)[:, None], (b, B_HEADS, s, B_ROPE))
    k = jnp.concatenate([kvf[..., :B_NOPE], k_rope], axis=-1)
    v = kvf[..., B_NOPE:]
    coef = jnp.ones((1,), jnp.float32)
    out = causal_attn(q[:, :, None], k[:, :, None], v, (B_NOPE + B_ROPE) ** -0.5, coef)
    return from_heads(out)


def mixer_diff(qc, kc, vc, lam_params, subln_g, lam_init, cos32, sin32):
    b, s, _ = qc.shape
    q = apply_rope(qc.reshape(b, s, C_HEADS, 2, C_QK).transpose(0, 2, 3, 1, 4), cos32, sin32)
    k = apply_rope(kc.reshape(b, s, C_HEADS, 2, C_QK).transpose(0, 2, 3, 1, 4), cos32, sin32)
    v = to_heads(vc, C_HEADS)
    lp = lam_params.astype(jnp.float32)
    lam = jnp.exp(jnp.sum(lp[0] * lp[1])) - jnp.exp(jnp.sum(lp[2] * lp[3])) + lam_init
    coef = jnp.stack([jnp.ones((), jnp.float32), -lam])
    out = causal_attn(q, k, v, C_QK ** -0.5, coef)
    out = rmsnorm(out, subln_g, C_SUBLN_EPS) * (1.0 - lam_init)
    return from_heads(out)


def setup_inputs(seed: int = 0) -> dict:
    key = jax.random.key(seed)
    ks = jax.random.split(key, 16)

    def nrm(k, shape, fan):
        return jax.random.normal(k, shape, jnp.float32) * (fan ** -0.5)

    def gain(k, shape):
        return 1.0 + 0.02 * jax.random.normal(k, shape, jnp.float32)

    return {
        "x": jax.random.normal(ks[0], (BATCH, SEQ, D_MODEL), jnp.float32),
        "ln1_g": gain(ks[1], (DEPTH, D_MODEL)),
        "w_in": nrm(ks[2], (DEPTH, D_MODEL, IN_COLS), D_MODEL),
        "mla_q_norm_g": gain(ks[3], (DEPTH, B_Q_LORA)),
        "mla_w_uq": nrm(ks[4], (DEPTH, B_Q_LORA, B_HEADS * (B_NOPE + B_ROPE)), B_Q_LORA),
        "mla_kv_norm_g": gain(ks[5], (DEPTH, B_KV_LORA)),
        "mla_w_ukv": nrm(ks[6], (DEPTH, B_KV_LORA, B_HEADS * (B_NOPE + B_V)), B_KV_LORA),
        "diff_lambda": 0.1 * jax.random.normal(ks[7], (DEPTH, 4, C_QK), jnp.float32),
        "diff_subln_g": gain(ks[8], (DEPTH, C_V)),
        "w_o": nrm(ks[9], (DEPTH, MIX_WIDTH, D_MODEL), MIX_WIDTH),
        "ln2_g": gain(ks[10], (DEPTH, D_MODEL)),
        "w_up": nrm(ks[11], (DEPTH, D_MODEL, D_FF), D_MODEL),
        "w_down": nrm(ks[12], (DEPTH, D_FF, D_MODEL), D_FF),
        "final_g": gain(ks[13], (D_MODEL,)),
    }


def reference(x, ln1_g, w_in, mla_q_norm_g, mla_w_uq, mla_kv_norm_g, mla_w_ukv,
              diff_lambda, diff_subln_g, w_o, ln2_g, w_up, w_down, final_g):
    s = x.shape[1]
    cos64, sin64 = rope_tables(s, A_HEAD_DIM)
    cos32, sin32 = rope_tables(s, C_QK)
    split_idx = [int(v) for v in np.cumsum(IN_SPLITS)[:-1]]

    for layer in range(DEPTH):
        lam_init = 0.8 - 0.6 * math.exp(-0.3 * layer)
        h = rmsnorm(x, ln1_g[layer])
        proj = h @ w_in[layer]
        qa, ka, va, cq, ckv, kr, qc, kc, vc = jnp.split(proj, split_idx, axis=-1)

        out_a = mixer_dilated(qa, ka, va, cos64, sin64)
        out_b = mixer_mla(cq, ckv, kr, mla_q_norm_g[layer], mla_w_uq[layer],
                          mla_kv_norm_g[layer], mla_w_ukv[layer], cos32, sin32)
        out_c = mixer_diff(qc, kc, vc, diff_lambda[layer], diff_subln_g[layer], lam_init, cos32, sin32)

        mixed = jnp.concatenate([out_a, out_b, out_c], axis=-1)
        x = x + mixed @ w_o[layer]

        u = rmsnorm(x, ln2_g[layer]) @ w_up[layer]
        x = x + jnp.square(jax.nn.relu(u)) @ w_down[layer]

    return rmsnorm(x, final_g)
```

```cpp
#include <hip/hip_runtime.h>
#include <hip/hip_cooperative_groups.h>
#include <cstdio>
#include <cstdint>
#include <cmath>
namespace cg = cooperative_groups;

namespace pg8 {
#define PG8_LAS __attribute__((address_space(3)))
typedef unsigned short bf16_t;
typedef short bf16x8 __attribute__((ext_vector_type(8)));
typedef float f32x4 __attribute__((ext_vector_type(4)));
typedef unsigned u32x4 __attribute__((ext_vector_type(4)));
constexpr int BM = 256, BK = 64, HALF = 128, HTB = HALF * BK * 2  , STAGE_BYTES = 8 * HTB, NXCD = 8, WGM = 8;

__host__ __device__ __forceinline__ int lds_byte(int r, int c) { const int st = (r >> 4) * 2 + (c >> 5), rr = r & 15, cc = c & 31, ob = rr * 64 + cc * 2; return st * 1024 + (ob ^ (((ob >> 9) & 1) << 5)); }
__host__ __device__ __forceinline__ void stage_rc(int b, int& R, int& C) { const int st = b / 1024, sb = b % 1024, swz = sb ^ (((sb >> 9) & 1) << 5); R = (st >> 1) * 16 + swz / 64; C = (st & 1) * 32 + (swz % 64) / 2; }
__host__ __device__ __forceinline__ int perm32(int rho) { const int n = rho >> 4, i = rho & 15; return 8 * (i >> 2) + 4 * n + (i & 3); }

struct Unit { int pm, pn; };
struct Gemm { const bf16_t* A; const bf16_t* Bt; int M, N, K, lda; };

struct StaticOrder {
    int nM, nN, nwg, G, c;
    __host__ __device__ void init(int M, int N, int G_, int c_) { nM = M / BM; nN = N / BM; nwg = nM * nN; G = G_; c = c_; }
    __host__ __device__ bool next(int i, Unit& u) const {
        const long L = (long)i * G + c; if (L >= nwg) return false;
        int wgid = (int)L; { const int q = nwg / NXCD, r = nwg % NXCD, xcd = wgid % NXCD, off = wgid / NXCD; wgid = (xcd < r ? xcd * (q + 1) : r * (q + 1) + (xcd - r) * q) + off; }
        const int nig = WGM * nN, gid = wgid / nig, fm = gid * WGM, gsz = (nM - fm) < WGM ? (nM - fm) : WGM;
        u.pm = fm + ((wgid % nig) % gsz); u.pn = (wgid % nig) / gsz; return true;
    }
    __device__ __forceinline__ void a_ready(const Unit&) const {}
    __device__ __forceinline__ void done(const Unit&) const {}
};

__device__ __forceinline__ unsigned cvt_pk_bf16(float lo, float hi) { unsigned r; asm volatile("v_cvt_pk_bf16_f32 %0, %1, %2" : "=v"(r) : "v"(lo), "v"(hi)); return r; }
template <class Epi, class Sched, class Tab, bool ALIGN_EPI = false, bool SP2 = false>
__device__ __forceinline__ void gemm_phase(PG8_LAS unsigned char* lds, const Gemm g, const Sched& S, const Epi& E, const Tab& T) {
    int tid_ = threadIdx.x; asm volatile("" : "+v"(tid_));
    const int tid = tid_, wid = __builtin_amdgcn_readfirstlane(tid >> 6), lane = tid & 63, wr = wid >> 2, wc = wid & 3, fr = lane & 15, fq = lane >> 4;
    const int K = g.K, nt = K / BK;
    unsigned voffA[2], voffB[2];
#pragma unroll
    for (int i = 0; i < 2; ++i) { int R, C; stage_rc(tid * 16 + i * 8192, R, C); const int Rb = Epi::PERM ? ((R & ~31) + perm32(R & 31)) : R;
        voffA[i] = (unsigned)(R * g.lda + C) * 2u; voffB[i] = (unsigned)(Rb * K + C) * 2u; }
    const size_t kstep = (size_t)(BK * 2);
    const size_t hstepA = (size_t)HALF * g.lda * 2, hstepB = (size_t)HALF * K * 2;
    const size_t tstepA = 2 * hstepA, tstepB = 2 * hstepB;
    const unsigned ldsw = (unsigned)wid * 1024u;
    const int aoff = lds_byte(wr * 64 + fr, fq * 8), boff = lds_byte(wc * 32 + fr, fq * 8);
#define PG8_SA(b, h) (((b) * 2 + (h)) * HTB)
#define PG8_SB(b, h) ((4 + (b) * 2 + (h)) * HTB)
#define PG8_STAGE(bufoff, gbase, voff) do { _Pragma("unroll") for (int _i = 0; _i < 2; ++_i) \
        __builtin_amdgcn_global_load_lds((const unsigned*)((const char*)(gbase) + (voff)[_i]), (PG8_LAS unsigned*)(lds + (bufoff) + ldsw + _i * 8192), 16, 0, 0); } while (0)
#define PG8_LDA(dst, b, h) do { _Pragma("unroll") for (int m = 0; m < 4; ++m) _Pragma("unroll") for (int k = 0; k < 2; ++k) dst[m][k] = *(const PG8_LAS bf16x8*)(lds + PG8_SA(b, h) + aoff + m * 2048 + k * 1024); } while (0)
#define PG8_LDB(dst, b, h) do { _Pragma("unroll") for (int n = 0; n < 2; ++n) _Pragma("unroll") for (int k = 0; k < 2; ++k) dst[n][k] = *(const PG8_LAS bf16x8*)(lds + PG8_SB(b, h) + boff + n * 2048 + k * 1024); } while (0)
#define PG8_MMA(ai, bj, At, Bt) do { __builtin_amdgcn_s_setprio(1); _Pragma("unroll") for (int m = 0; m < 4; ++m) _Pragma("unroll") for (int n = 0; n < 2; ++n) _Pragma("unroll") for (int k = 0; k < 2; ++k) \
        acc[ai][bj][m][n] = __builtin_amdgcn_mfma_f32_16x16x32_bf16(Bt[n][k], At[m][k], acc[ai][bj][m][n], 0, 0, 0); __builtin_amdgcn_s_setprio(0); } while (0)
#define PG8_WAIT_V(n) asm volatile("s_waitcnt vmcnt(" #n ")" ::: "memory")
#define PG8_WAIT_L(n) asm volatile("s_waitcnt lgkmcnt(" #n ")" ::: "memory")
#define PG8_BAR __builtin_amdgcn_s_barrier()
#define PG8_SCHED __builtin_amdgcn_sched_barrier(0)
    Unit cur, nxt; int ui = 0;
    if (!S.next(0, cur)) return;
    f32x4 acc[2][2][4][2];
#pragma unroll
    for (int a = 0; a < 2; ++a)
#pragma unroll
        for (int b = 0; b < 2; ++b)
#pragma unroll
            for (int m = 0; m < 4; ++m)
#pragma unroll
                for (int n = 0; n < 2; ++n) acc[a][b][m][n] = (f32x4){0.f, 0.f, 0.f, 0.f};
    bf16x8 At[4][2], B0[2][2], B1[2][2];
    const char* cA = (const char*)g.A + (size_t)cur.pm * tstepA; const char* cB = (const char*)g.Bt + (size_t)cur.pn * tstepB;
    T.fill(cur, (PG8_LAS float*)(lds + STAGE_BYTES));
    if constexpr (SP2) {
        PG8_STAGE(PG8_SB(0, 0), cB, voffB); PG8_STAGE(PG8_SB(0, 1), cB + hstepB, voffB); PG8_STAGE(PG8_SA(0, 0), cA, voffA); PG8_STAGE(PG8_SA(0, 1), cA + hstepA, voffA);
        if (wr == 1) PG8_BAR;
        PG8_WAIT_V(2); PG8_BAR;
        PG8_STAGE(PG8_SB(1, 0), cB + kstep, voffB); PG8_STAGE(PG8_SA(1, 0), cA + kstep, voffA); PG8_STAGE(PG8_SB(1, 1), cB + hstepB + kstep, voffB);
        PG8_WAIT_V(6); PG8_BAR;
    } else {
        PG8_STAGE(PG8_SB(0, 0), cB, voffB); PG8_STAGE(PG8_SA(0, 0), cA, voffA); PG8_STAGE(PG8_SB(0, 1), cB + hstepB, voffB); PG8_STAGE(PG8_SA(0, 1), cA + hstepA, voffA);
        if (wr == 1) PG8_BAR;
        PG8_WAIT_V(4); PG8_BAR;
        PG8_STAGE(PG8_SB(1, 0), cB + kstep, voffB); PG8_STAGE(PG8_SA(1, 0), cA + kstep, voffA); PG8_STAGE(PG8_SB(1, 1), cB + hstepB + kstep, voffB);
        PG8_WAIT_V(6); PG8_BAR;
    }
    for (;;) {
        const bool has_next = S.next(ui + 1, nxt);
        const char* nA = has_next ? (const char*)g.A + (size_t)nxt.pm * tstepA : cA; const char* nB = has_next ? (const char*)g.Bt + (size_t)nxt.pn * tstepB : cB;
        for (int t = 0; t < nt; t += 2) {
            const bool last = (t == nt - 2);
            const char* a1 = cA + (size_t)(t + 1) * kstep;
            const char* a2 = last ? nA : cA + (size_t)(t + 2) * kstep; const char* b2 = last ? nB : cB + (size_t)(t + 2) * kstep;
            const char* a3 = a2 + kstep; const char* b3 = b2 + kstep;
            if (last && has_next) T.fill(nxt, (PG8_LAS float*)(lds + STAGE_BYTES + ((ui + 1) & 1) * 1024));
            if constexpr (SP2) {
            PG8_LDB(B0, 0, 0); PG8_LDB(B1, 0, 1); PG8_SCHED; PG8_LDA(At, 0, 0); PG8_STAGE(PG8_SA(1, 1), a1 + hstepA, voffA);
            PG8_WAIT_V(8); PG8_WAIT_L(0); PG8_BAR; PG8_MMA(0, 0, At, B0); PG8_MMA(0, 1, At, B1); PG8_BAR; PG8_SCHED;
            PG8_LDA(At, 0, 1); PG8_STAGE(PG8_SB(0, 0), b2, voffB); PG8_STAGE(PG8_SB(0, 1), b2 + hstepB, voffB); PG8_STAGE(PG8_SA(0, 0), a2, voffA);
            PG8_WAIT_V(8); PG8_WAIT_L(0); PG8_BAR; PG8_MMA(1, 0, At, B0); PG8_MMA(1, 1, At, B1); PG8_BAR; PG8_SCHED;
            PG8_LDB(B0, 1, 0); PG8_LDB(B1, 1, 1); PG8_SCHED; PG8_LDA(At, 1, 0); PG8_STAGE(PG8_SA(0, 1), a2 + hstepA, voffA);
            PG8_WAIT_V(8); PG8_WAIT_L(0); PG8_BAR; PG8_MMA(0, 0, At, B0); PG8_MMA(0, 1, At, B1); PG8_BAR; PG8_SCHED;
            PG8_LDA(At, 1, 1); PG8_STAGE(PG8_SB(1, 0), b3, voffB); PG8_STAGE(PG8_SB(1, 1), b3 + hstepB, voffB); PG8_STAGE(PG8_SA(1, 0), a3, voffA);
            PG8_WAIT_V(8); PG8_WAIT_L(0); PG8_BAR; PG8_MMA(1, 0, At, B0); PG8_MMA(1, 1, At, B1); PG8_BAR; PG8_SCHED;
            } else {
            PG8_LDB(B0, 0, 0); PG8_SCHED; PG8_LDA(At, 0, 0); PG8_STAGE(PG8_SA(1, 1), a1 + hstepA, voffA);
            PG8_WAIT_L(8); PG8_BAR; PG8_WAIT_L(0); PG8_MMA(0, 0, At, B0); PG8_BAR; PG8_SCHED;
            PG8_LDB(B1, 0, 1); PG8_STAGE(PG8_SB(0, 0), b2, voffB);
            PG8_BAR; PG8_WAIT_L(0); PG8_MMA(0, 1, At, B1); PG8_BAR;
            PG8_LDA(At, 0, 1); PG8_STAGE(PG8_SA(0, 0), a2, voffA);
            PG8_BAR; PG8_WAIT_L(0); PG8_MMA(1, 0, At, B0); PG8_BAR; PG8_SCHED;
            PG8_STAGE(PG8_SB(0, 1), b2 + hstepB, voffB);
            PG8_WAIT_V(6); PG8_BAR; PG8_MMA(1, 1, At, B1); PG8_BAR;
            PG8_LDB(B0, 1, 0); PG8_SCHED; PG8_LDA(At, 1, 0); PG8_STAGE(PG8_SA(0, 1), a2 + hstepA, voffA);
            PG8_WAIT_L(8); PG8_BAR; PG8_WAIT_L(0); PG8_MMA(0, 0, At, B0); PG8_BAR; PG8_SCHED;
            PG8_LDB(B1, 1, 1); PG8_STAGE(PG8_SB(1, 0), b3, voffB);
            PG8_BAR; PG8_WAIT_L(0); PG8_MMA(0, 1, At, B1); PG8_BAR;
            PG8_LDA(At, 1, 1); PG8_STAGE(PG8_SA(1, 0), a3, voffA);
            PG8_BAR; PG8_WAIT_L(0); PG8_MMA(1, 0, At, B0); PG8_BAR; PG8_SCHED;
            PG8_STAGE(PG8_SB(1, 1), b3 + hstepB, voffB);
            PG8_WAIT_V(6); PG8_BAR; PG8_MMA(1, 1, At, B1); PG8_BAR;
            }
        }
        if constexpr (ALIGN_EPI) { if (wr == 0) PG8_BAR; }
        E(acc, cur, wr, wc, fr, fq, (const PG8_LAS float*)(lds + STAGE_BYTES + (ui & 1) * 1024));
        if (!has_next) break;
#pragma unroll
        for (int a = 0; a < 2; ++a)
#pragma unroll
            for (int b = 0; b < 2; ++b)
#pragma unroll
                for (int m = 0; m < 4; ++m)
#pragma unroll
                    for (int n = 0; n < 2; ++n) acc[a][b][m][n] = (f32x4){0.f, 0.f, 0.f, 0.f};
        cur = nxt; cA = nA; cB = nB; ++ui;
        if constexpr (ALIGN_EPI) { if (wr == 1) PG8_BAR; }
    }
    PG8_WAIT_V(0);
    if constexpr (!ALIGN_EPI) { if (wr == 0) PG8_BAR; }
    PG8_BAR;
#undef PG8_SA
#undef PG8_SB
#undef PG8_STAGE
#undef PG8_LDA
#undef PG8_LDB
#undef PG8_MMA
#undef PG8_WAIT_V
#undef PG8_WAIT_L
#undef PG8_BAR
#undef PG8_SCHED
}
}

#define LAS __attribute__((address_space(3)))
typedef unsigned short bf16_t;
typedef short bf16x8 __attribute__((ext_vector_type(8)));
typedef float f32x4 __attribute__((ext_vector_type(4)));
typedef float f32x16 __attribute__((ext_vector_type(16)));
typedef unsigned u32x4 __attribute__((ext_vector_type(4)));
typedef unsigned u32x2 __attribute__((ext_vector_type(2)));

constexpr int BATCH = 2, SEQ = 8192, M = BATCH * SEQ, DM = 1024, NIN = 2560, FF = 4096;
constexpr float LOG2E = 1.4426950408889634f;
constexpr float SC_A = 0.125f * LOG2E, SC_B = 0.10206207261596575f * LOG2E, SC_C = 0.17677669529663687f * LOG2E;
constexpr float EPS = 1e-6f;

constexpr size_t MiB = 1u << 20;
constexpr size_t WS_CTL = 0;
constexpr size_t WS_COS64 = 1 * MiB, WS_SIN64 = 2 * MiB, WS_COS32 = 3 * MiB, WS_SIN32 = 3 * MiB + 512 * 1024;
constexpr size_t WS_SS1 = 4 * MiB, WS_SS2 = 5 * MiB, WS_LSE = 6 * MiB, WS_LAM = 7 * MiB + 512 * 1024;
constexpr size_t WS_W = 8 * MiB, W_LAYER = 24 * MiB;
constexpr size_t W_IN = 0, W_UQ = 5 * MiB, W_UKV = 5 * MiB + 768 * 1024, W_O = 6 * MiB, W_UP = 8 * MiB, W_DN = 16 * MiB;
constexpr size_t WS_XB = 56 * MiB, WS_OA = 56 * MiB, WS_MIX = 92 * MiB, WS_P = 124 * MiB, WS_QB = 204 * MiB, WS_KVB = 228 * MiB, WS_H = 124 * MiB, WS_END = 252 * MiB;
constexpr int LDS_BYTES = 147456;
constexpr int LDS_TAB = 131072, LDS_MISC = 131072 + 4096;

__device__ __forceinline__ float bf_lo(unsigned w) { return __uint_as_float(w << 16); }
__device__ __forceinline__ float bf_hi(unsigned w) { return __uint_as_float(w & 0xffff0000u); }
template <int PAT> __device__ __forceinline__ float swz(float v) { return __builtin_bit_cast(float, __builtin_amdgcn_ds_swizzle(__builtin_bit_cast(int, v), PAT)); }
__device__ __forceinline__ float xsum32(float v) { auto rr = __builtin_amdgcn_permlane32_swap(__float_as_uint(v), __float_as_uint(v), false, false); return __uint_as_float(rr[0]) + __uint_as_float(rr[1]); }
__device__ __forceinline__ u32x4 pack8(f32x4 a, f32x4 b) {
    u32x4 w; w.x = pg8::cvt_pk_bf16(a[0], a[1]); w.y = pg8::cvt_pk_bf16(a[2], a[3]); w.z = pg8::cvt_pk_bf16(b[0], b[1]); w.w = pg8::cvt_pk_bf16(b[2], b[3]); return w;
}
__device__ __forceinline__ void rope8(f32x4& a, f32x4& b, f32x4 cs, f32x4 sn) {
    float x, y;
    x = a[0]; y = a[1]; a[0] = x * cs[0] - y * sn[0]; a[1] = x * sn[0] + y * cs[0];
    x = a[2]; y = a[3]; a[2] = x * cs[1] - y * sn[1]; a[3] = x * sn[1] + y * cs[1];
    x = b[0]; y = b[1]; b[0] = x * cs[2] - y * sn[2]; b[1] = x * sn[2] + y * cs[2];
    x = b[2]; y = b[3]; b[2] = x * cs[3] - y * sn[3]; b[3] = x * sn[3] + y * cs[3];
}

struct TabNone { __device__ __forceinline__ void fill(const pg8::Unit&, LAS float*) const {} };
struct TabSS {
    const float* ss;
    __device__ __forceinline__ void fill(const pg8::Unit& u, LAS float* tab) const {
        int tid = threadIdx.x; asm volatile("" : "+v"(tid));
        if (tid < 256) {
            const f32x4* p = (const f32x4*)(ss + (size_t)(u.pm * 256 + tid) * 16);
            f32x4 s = p[0]; s = s + p[1]; s = s + p[2]; s = s + p[3];
            const float t = (s[0] + s[1]) + (s[2] + s[3]);
            tab[tid] = __builtin_amdgcn_rsqf(t * (1.f / 1024.f) + EPS);
        }
    }
};
template <int NCOLS> struct TabRows {
    const bf16_t* base; int pitch;
    __device__ __forceinline__ void fill(const pg8::Unit& u, LAS float* tab) const {
        int tid = threadIdx.x; asm volatile("" : "+v"(tid));
        const u32x4* p = (const u32x4*)(base + (size_t)(u.pm * 256 + (tid >> 1)) * pitch + (tid & 1) * (NCOLS / 2));
        float s = 0.f;
#pragma unroll 4
        for (int i = 0; i < NCOLS / 16; ++i) {
            const u32x4 v = p[i];
            s += bf_lo(v.x) * bf_lo(v.x) + bf_hi(v.x) * bf_hi(v.x) + bf_lo(v.y) * bf_lo(v.y) + bf_hi(v.y) * bf_hi(v.y)
               + bf_lo(v.z) * bf_lo(v.z) + bf_hi(v.z) * bf_hi(v.z) + bf_lo(v.w) * bf_lo(v.w) + bf_hi(v.w) * bf_hi(v.w);
        }
        s += swz<0x041f>(s);
        if (!(tid & 1)) tab[tid >> 1] = __builtin_amdgcn_rsqf(s * (1.f / NCOLS) + EPS);
    }
};

#define EPI_ROWS_BEGIN _Pragma("unroll") for (int ai = 0; ai < 2; ++ai) _Pragma("unroll") for (int m = 0; m < 4; ++m) { const int rl = ai * 128 + wr * 64 + m * 16 + fr; const int row = u.pm * 256 + rl;
#define EPI_ROWS_END }

struct EpiInProj {
    static constexpr bool PERM = true;
    bf16_t* P; const float* c64; const float* s64; const float* c32; const float* s32;
    __device__ __forceinline__ void operator()(const f32x4 (&acc)[2][2][4][2], const pg8::Unit& u, int wr, int wc, int fr, int fq, const LAS float* tab) const {
#pragma unroll
        for (int bj = 0; bj < 2; ++bj) {
            const int cb = u.pn * 256 + bj * 128 + wc * 32, c0 = cb + 8 * fq;
            int typ = 0; float sc = 1.f;
            if (cb < 384) { typ = 1; sc = SC_A; } else if (cb < 768) typ = 1; else if (cb < 1664) typ = 0; else if (cb < 1696) typ = 2;
            else if (cb < 1792) typ = 0; else if (cb < 2048) { typ = 2; sc = SC_C; } else if (cb < 2304) typ = 2;
            EPI_ROWS_BEGIN
                const float rs = tab[rl] * sc;
                f32x4 v0 = acc[ai][bj][m][0] * rs, v1 = acc[ai][bj][m][1] * rs;
                if (typ == 1) { const int o = (row & (SEQ - 1)) * 32 + ((c0 & 63) >> 1); rope8(v0, v1, *(const f32x4*)(c64 + o), *(const f32x4*)(s64 + o)); }
                else if (typ == 2) { const int o = (row & (SEQ - 1)) * 16 + ((c0 & 31) >> 1); rope8(v0, v1, *(const f32x4*)(c32 + o), *(const f32x4*)(s32 + o)); }
                *(u32x4*)(P + (size_t)row * NIN + c0) = pack8(v0, v1);
            EPI_ROWS_END
        }
    }
};
struct EpiUq {
    static constexpr bool PERM = true;
    bf16_t* Q; const float* c32; const float* s32;
    __device__ __forceinline__ void operator()(const f32x4 (&acc)[2][2][4][2], const pg8::Unit& u, int wr, int wc, int fr, int fq, const LAS float* tab) const {
#pragma unroll
        for (int bj = 0; bj < 2; ++bj) {
            const int c0 = u.pn * 256 + bj * 128 + wc * 32 + 8 * fq;
            const bool ok = c0 < 576; const int h = c0 / 96, p = c0 - 96 * h; const bool rp = ok && p >= 64; const int i0 = rp ? ((p - 64) >> 1) : 0;
            EPI_ROWS_BEGIN
                const float rs = tab[rl] * SC_B;
                f32x4 v0 = acc[ai][bj][m][0] * rs, v1 = acc[ai][bj][m][1] * rs;
                const int o = (row & (SEQ - 1)) * 16 + i0;
                f32x4 cs = *(const f32x4*)(c32 + o), sn = *(const f32x4*)(s32 + o);
                if (!rp) { cs = (f32x4){1.f, 1.f, 1.f, 1.f}; sn = (f32x4){0.f, 0.f, 0.f, 0.f}; }
                rope8(v0, v1, cs, sn);
                if (ok) *(u32x4*)(Q + (size_t)row * 768 + c0) = pack8(v0, v1);
            EPI_ROWS_END
        }
    }
};
template <int ACT  > struct EpiScaled {
    static constexpr bool PERM = true;
    bf16_t* O; int ldc;
    __device__ __forceinline__ void operator()(const f32x4 (&acc)[2][2][4][2], const pg8::Unit& u, int wr, int wc, int fr, int fq, const LAS float* tab) const {
        EPI_ROWS_BEGIN
            const float rs = tab[rl];
#pragma unroll
            for (int bj = 0; bj < 2; ++bj) {
                const int c0 = u.pn * 256 + bj * 128 + wc * 32 + 8 * fq;
                f32x4 v0 = acc[ai][bj][m][0] * rs, v1 = acc[ai][bj][m][1] * rs;
                if (ACT == 1) {
#pragma unroll
                    for (int k = 0; k < 4; ++k) { const float a = fmaxf(v0[k], 0.f), b = fmaxf(v1[k], 0.f); v0[k] = a * a; v1[k] = b * b; }
                }
                *(u32x4*)(O + (size_t)row * ldc + c0) = pack8(v0, v1);
            }
        EPI_ROWS_END
    }
};
struct EpiResid {
    static constexpr bool PERM = true;
    const float* xin; float* xout; bf16_t* xb; float* ss;
    __device__ __forceinline__ void operator()(const f32x4 (&acc)[2][2][4][2], const pg8::Unit& u, int wr, int wc, int fr, int fq, const LAS float*) const {
        EPI_ROWS_BEGIN
            float sq = 0.f;
#pragma unroll
            for (int bj = 0; bj < 2; ++bj) {
                const size_t off = (size_t)row * DM + u.pn * 256 + bj * 128 + wc * 32 + 8 * fq;
                const f32x4 r0 = *(const f32x4*)(xin + off), r1 = *(const f32x4*)(xin + off + 4);
                const f32x4 v0 = r0 + acc[ai][bj][m][0], v1 = r1 + acc[ai][bj][m][1];
                *(f32x4*)(xout + off) = v0; *(f32x4*)(xout + off + 4) = v1;
                *(u32x4*)(xb + off) = pack8(v0, v1);
                sq += (v0[0] * v0[0] + v0[1] * v0[1]) + (v0[2] * v0[2] + v0[3] * v0[3]) + (v1[0] * v1[0] + v1[1] * v1[1]) + (v1[2] * v1[2] + v1[3] * v1[3]);
            }
            sq += swz<0x401f>(sq); sq = xsum32(sq);
            if (fq == 0) ss[(size_t)row * 16 + u.pn * 4 + wc] = sq;
        EPI_ROWS_END
    }
};

struct AttnBufs { const bf16_t* P; const bf16_t* QB; const bf16_t* KVB; bf16_t* OA; float* LSE; bf16_t* MIX; const float* subg; float lam; float oml; };
namespace att {
constexpr int KSTR = 1040, VOFF = 12544, VDH = 4160, BUFB = 20992, OST = 2 * BUFB, OSTW = 4608;
constexpr float NEG = -1e30f;
typedef short v4i16_t __attribute__((ext_vector_type(4)));
__device__ __forceinline__ int crow(int r, int hi) { return (r & 3) + 8 * (r >> 2) + 4 * hi; }
__device__ __forceinline__ v4i16_t vtr(const LAS unsigned char* p) { return __builtin_amdgcn_ds_read_tr16_b64_v4i16((LAS v4i16_t*)p); }
__device__ __forceinline__ float swapmax(float v) { auto rr = __builtin_amdgcn_permlane32_swap(__float_as_uint(v), __float_as_uint(v), false, false); return fmaxf(__uint_as_float(rr[0]), __uint_as_float(rr[1])); }
__device__ __forceinline__ float swapsum(float v) { auto rr = __builtin_amdgcn_permlane32_swap(__float_as_uint(v), __float_as_uint(v), false, false); return __uint_as_float(rr[0]) + __uint_as_float(rr[1]); }

template <int TYPE>
__device__ __forceinline__ void attn_unit(LAS unsigned char* lds, const AttnBufs& A, int b, int h, int qb, int cfg, int res) {
    constexpr int DQ = TYPE == 0 ? 64 : (TYPE == 1 ? 96 : 32), NMAP = TYPE == 2 ? 2 : 1, NCH = NMAP * DQ / 8, NQF = NMAP * DQ / 16, NDS = DQ / 16;
    constexpr int NC1 = TYPE == 1 ? 8 : NCH, NKP = NCH * 64;
    constexpr bool BAND = TYPE == 0;
    int tid_ = threadIdx.x; asm volatile("" : "+v"(tid_));
    const int tid = tid_, lane = tid & 63, r32 = lane & 31, hi = lane >> 5;
    const int wid = __builtin_amdgcn_readfirstlane(tid >> 6);
    const int dil = (TYPE == 0) ? (cfg == 0 ? 1 : (cfg == 1 ? 4 : 16)) : 1;
    const long rowbase = (long)b * SEQ + res;
    const bf16_t *Qp, *K1p, *K2p, *Vp; int pQ, pK1, pK2, pV;
    if (TYPE == 0) { Qp = A.P + h * 64; pQ = NIN; K1p = A.P + 384 + h * 64; pK1 = NIN; K2p = K1p; pK2 = NIN; Vp = A.P + 768 + h * 64; pV = NIN; }
    else if (TYPE == 1) { Qp = A.QB + h * 96; pQ = 768; K1p = A.KVB + h * 128; pK1 = 768; K2p = A.P + 1664; pK2 = NIN; Vp = A.KVB + h * 128 + 64; pV = 768; }
    else { Qp = A.P + 1792 + h * 64; pQ = NIN; K1p = A.P + 2048 + h * 64; pK1 = NIN; K2p = K1p; pK2 = NIN; Vp = A.P + 2304 + h * 64; pV = NIN; }
    const int q0 = qb * 256, qw0 = q0 + wid * 32;
    const int kt_lo = BAND ? (qb > 0 ? 4 * qb - 2 : 0) : 0, kt_hi = 4 * qb + 4;
    bf16x8 qf[NQF];
    { const bf16_t* qrow = Qp + (rowbase + (long)dil * (qw0 + r32)) * pQ + hi * 8;
#pragma unroll
      for (int f = 0; f < NQF; ++f) qf[f] = *(const bf16x8*)(qrow + f * 16); }
    const int krow0 = tid / NCH, kch0 = tid % NCH, krow1 = (tid + 512) / NCH, kch1 = (tid + 512) % NCH;
    const bool k1ok = (NKP > 512) && (tid + 512 < NKP);
    const int vrow = tid >> 3, vch = tid & 7;
    const int kdst0 = kch0 * KSTR + krow0 * 16, kdst1 = kch1 * KSTR + krow1 * 16, vdst = VOFF + (vch >> 2) * VDH + vrow * 64 + (vch & 3) * 16;
    u32x4 kr0, kr1 = (u32x4){0u, 0u, 0u, 0u}, vr;
#define ATT_LOADT(kt) do { \
        { const long g = rowbase + (long)dil * (64 * (kt) + krow0); const bf16_t* s = (kch0 < NC1) ? (K1p + g * pK1 + kch0 * 8) : (K2p + g * pK2 + (kch0 - NC1) * 8); kr0 = *(const u32x4*)s; } \
        if (k1ok) { const long g = rowbase + (long)dil * (64 * (kt) + krow1); const bf16_t* s = (kch1 < NC1) ? (K1p + g * pK1 + kch1 * 8) : (K2p + g * pK2 + (kch1 - NC1) * 8); kr1 = *(const u32x4*)s; } \
        { const long g = rowbase + (long)dil * (64 * (kt) + vrow); vr = *(const u32x4*)(Vp + g * pV + vch * 8); } } while (0)
#define ATT_STORET(bo) do { *(LAS u32x4*)(lds + (bo) + kdst0) = kr0; if (k1ok) *(LAS u32x4*)(lds + (bo) + kdst1) = kr1; *(LAS u32x4*)(lds + (bo) + vdst) = vr; } while (0)
    f32x16 o[NMAP][2]; float mrun[NMAP], lrun[NMAP];
#pragma unroll
    for (int mp = 0; mp < NMAP; ++mp) { mrun[mp] = NEG; lrun[mp] = 0.f;
#pragma unroll
        for (int d0 = 0; d0 < 2; ++d0)
#pragma unroll
            for (int r = 0; r < 16; ++r) o[mp][d0][r] = 0.f; }
    const int kofs = hi * KSTR + r32 * 16;
    const int vofs = VOFF + ((lane >> 4) & 1) * 32 + (lane & 3) * 8 + (4 * hi + ((lane & 15) >> 2)) * 64;
    ATT_LOADT(kt_lo); ATT_STORET(0);
    __syncthreads();
    int cur = 0;
    for (int kt = kt_lo; kt < kt_hi; ++kt) {
        const bool more = kt + 1 < kt_hi;
        if (more) ATT_LOADT(kt + 1);
        const int kmin = 64 * kt, kmax = kmin + 63;
        bool active = kmin <= qw0 + 31; if (BAND) active = active && (kmax + 128 >= qw0);
        if (active) {
            const LAS unsigned char* Kb = lds + cur * BUFB;
            f32x16 s0[NMAP], s1[NMAP];
#pragma unroll
            for (int mp = 0; mp < NMAP; ++mp) {
#pragma unroll
                for (int r = 0; r < 16; ++r) { s0[mp][r] = 0.f; s1[mp][r] = 0.f; }
#pragma unroll
                for (int ds = 0; ds < NDS; ++ds) {
                    const bf16x8 k0 = *(const LAS bf16x8*)(Kb + kofs + (mp * (DQ / 8) + 2 * ds) * KSTR);
                    const bf16x8 k1 = *(const LAS bf16x8*)(Kb + kofs + (mp * (DQ / 8) + 2 * ds) * KSTR + 512);
                    s0[mp] = __builtin_amdgcn_mfma_f32_32x32x16_bf16(k0, qf[mp * NDS + ds], s0[mp], 0, 0, 0);
                    s1[mp] = __builtin_amdgcn_mfma_f32_32x32x16_bf16(k1, qf[mp * NDS + ds], s1[mp], 0, 0, 0);
                }
            }
            bool needmask = kmax > qw0; if (BAND) needmask = needmask || (kmin + 128 < qw0 + 31);
            if (needmask) {
                const int qpos = qw0 + r32;
#pragma unroll
                for (int r = 0; r < 16; ++r) {
                    const int kv0 = kmin + crow(r, hi), kv1 = kv0 + 32;
                    bool ok0 = kv0 <= qpos, ok1 = kv1 <= qpos;
                    if (BAND) { ok0 = ok0 && (kv0 + 128 >= qpos); ok1 = ok1 && (kv1 + 128 >= qpos); }
#pragma unroll
                    for (int mp = 0; mp < NMAP; ++mp) { s0[mp][r] = ok0 ? s0[mp][r] : NEG; s1[mp][r] = ok1 ? s1[mp][r] : NEG; }
                }
            }
            u32x4 pw[NMAP][4];
#pragma unroll
            for (int mp = 0; mp < NMAP; ++mp) {
                float rm = fmaxf(s0[mp][0], s1[mp][0]);
#pragma unroll
                for (int r = 1; r < 16; ++r) rm = fmaxf(rm, fmaxf(s0[mp][r], s1[mp][r]));
                rm = swapmax(rm);
                const float mn = fmaxf(mrun[mp], rm), alpha = __builtin_amdgcn_exp2f(mrun[mp] - mn); mrun[mp] = mn;
                float ps = 0.f;
#pragma unroll
                for (int r = 0; r < 16; ++r) { s0[mp][r] = __builtin_amdgcn_exp2f(s0[mp][r] - mn); s1[mp][r] = __builtin_amdgcn_exp2f(s1[mp][r] - mn); ps += s0[mp][r] + s1[mp][r]; }
                lrun[mp] = lrun[mp] * alpha + ps;
#pragma unroll
                for (int d0 = 0; d0 < 2; ++d0)
#pragma unroll
                    for (int r = 0; r < 16; ++r) o[mp][d0][r] *= alpha;
#pragma unroll
                for (int k = 0; k < 2; ++k) {
                    pw[mp][k]     = (u32x4){pg8::cvt_pk_bf16(s0[mp][8 * k], s0[mp][8 * k + 1]), pg8::cvt_pk_bf16(s0[mp][8 * k + 2], s0[mp][8 * k + 3]), pg8::cvt_pk_bf16(s0[mp][8 * k + 4], s0[mp][8 * k + 5]), pg8::cvt_pk_bf16(s0[mp][8 * k + 6], s0[mp][8 * k + 7])};
                    pw[mp][2 + k] = (u32x4){pg8::cvt_pk_bf16(s1[mp][8 * k], s1[mp][8 * k + 1]), pg8::cvt_pk_bf16(s1[mp][8 * k + 2], s1[mp][8 * k + 3]), pg8::cvt_pk_bf16(s1[mp][8 * k + 4], s1[mp][8 * k + 5]), pg8::cvt_pk_bf16(s1[mp][8 * k + 6], s1[mp][8 * k + 7])};
                }
            }
            const LAS unsigned char* Vb = Kb + vofs;
#pragma unroll
            for (int ks = 0; ks < 4; ++ks)
#pragma unroll
                for (int d0 = 0; d0 < 2; ++d0) {
                    const v4i16_t lo = vtr(Vb + d0 * VDH + ks * 1024), hh = vtr(Vb + d0 * VDH + ks * 1024 + 512);
                    const bf16x8 vf = (bf16x8){lo[0], lo[1], lo[2], lo[3], hh[0], hh[1], hh[2], hh[3]};
#pragma unroll
                    for (int mp = 0; mp < NMAP; ++mp) o[mp][d0] = __builtin_amdgcn_mfma_f32_32x32x16_bf16(vf, __builtin_bit_cast(bf16x8, pw[mp][ks]), o[mp][d0], 0, 0, 0);
                }
        }
        if (more) ATT_STORET((cur ^ 1) * BUFB);
        __syncthreads();
        cur ^= 1;
    }
#undef ATT_LOADT
#undef ATT_STORET
    float linv[NMAP], ltot[NMAP];
#pragma unroll
    for (int mp = 0; mp < NMAP; ++mp) { ltot[mp] = swapsum(lrun[mp]); linv[mp] = 1.f / ltot[mp]; }
    f32x16 val[2];
    if (TYPE == 2) {
        float sq = 0.f;
#pragma unroll
        for (int d0 = 0; d0 < 2; ++d0)
#pragma unroll
            for (int r = 0; r < 16; ++r) { const float v = o[0][d0][r] * linv[0] - A.lam * (o[NMAP - 1][d0][r] * linv[NMAP - 1]); val[d0][r] = v; sq += v * v; }
        sq = swapsum(sq);
        const float rs = __builtin_amdgcn_rsqf(sq * (1.f / 64.f) + 1e-5f) * A.oml;
#pragma unroll
        for (int d0 = 0; d0 < 2; ++d0)
#pragma unroll
            for (int g4 = 0; g4 < 4; ++g4) { const f32x4 gg = *(const f32x4*)(A.subg + 32 * d0 + 8 * g4 + 4 * hi);
#pragma unroll
                for (int k = 0; k < 4; ++k) val[d0][4 * g4 + k] *= rs * gg[k]; }
    } else {
#pragma unroll
        for (int d0 = 0; d0 < 2; ++d0)
#pragma unroll
            for (int r = 0; r < 16; ++r) val[d0][r] = o[0][d0][r] * linv[0];
    }
    LAS unsigned char* stg = lds + OST + wid * OSTW;
#pragma unroll
    for (int d0 = 0; d0 < 2; ++d0)
#pragma unroll
        for (int g4 = 0; g4 < 4; ++g4) {
            u32x2 w; w.x = pg8::cvt_pk_bf16(val[d0][4 * g4], val[d0][4 * g4 + 1]); w.y = pg8::cvt_pk_bf16(val[d0][4 * g4 + 2], val[d0][4 * g4 + 3]);
            *(LAS u32x2*)(stg + r32 * 144 + (32 * d0 + 8 * g4 + 4 * hi) * 2) = w;
        }
    bf16_t* Out; int pO;
    if (TYPE == 0) { Out = A.OA + (size_t)cfg * M * 384 + h * 64; pO = 384; }
    else if (TYPE == 1) { Out = A.MIX + 384 + h * 64; pO = DM; }
    else { Out = A.MIX + 768 + h * 64; pO = DM; }
#pragma unroll
    for (int i = 0; i < 4; ++i) {
        const int rr = 8 * i + (lane >> 3), ch = lane & 7;
        const u32x4 v = *(const LAS u32x4*)(stg + rr * 144 + ch * 16);
        *(u32x4*)(Out + (rowbase + (long)dil * (qw0 + rr)) * pO + ch * 8) = v;
    }
    if (TYPE == 0) { if (hi == 0) A.LSE[((size_t)cfg * M + rowbase + (long)dil * (qw0 + r32)) * 8 + h] = mrun[0] + __log2f(ltot[0]); }
}
}

constexpr int ATT_UNITS = 640 + 1152;
__device__ __forceinline__ void attn_phase(LAS unsigned char* lds, const AttnBufs& A, unsigned* ctr) {
    volatile LAS int* sh = (volatile LAS int*)(lds + LDS_MISC);
    for (;;) {
        if (threadIdx.x == 0) *sh = (int)atomicAdd(ctr, 1u);
        __syncthreads();
        const int idx = __builtin_amdgcn_readfirstlane(*sh);
        __syncthreads();
        if (idx >= ATT_UNITS) break;
        if (idx < 640) {
            const int qb = 31 - idx / 20, j = idx % 20;
            if (j < 12) att::attn_unit<1>(lds, A, j / 6, j % 6, qb, 0, 0);
            else att::attn_unit<2>(lds, A, (j - 12) / 4, (j - 12) % 4, qb, 0, 0);
        } else {
            const int a = idx - 640, cfg = a / 384, rem = a % 384, b = rem / 192, h = (rem / 32) % 6, tile = rem % 32;
            const int dl = cfg == 0 ? 1 : (cfg == 1 ? 4 : 16);
            att::attn_unit<0>(lds, A, b, h, tile / dl, cfg, tile % dl);
        }
    }
}

__device__ __forceinline__ float wave_sum(float v) {
    v += swz<0x041f>(v); v += swz<0x081f>(v); v += swz<0x101f>(v); v += swz<0x201f>(v); v += swz<0x401f>(v);
    return xsum32(v);
}
__device__ __forceinline__ int src_col(int kind, int n) {
    if (kind == 0) {
        if (n < 768) { const int blk = n >> 6, p = n & 63; return (blk << 6) + ((p & 1) ? 32 + (p >> 1) : (p >> 1)); }
        if (n < 1664) return n;
        if (n < 1696) { const int p = n - 1664; return 1664 + ((p & 1) ? 16 + (p >> 1) : (p >> 1)); }
        if (n < 1792) return -1;
        if (n < 2304) { const int q = n - 1792, blk = q >> 5, p = q & 31; return 1696 + (blk << 5) + ((p & 1) ? 16 + (p >> 1) : (p >> 1)); }
        return n - 96;
    }
    if (kind == 1) { if (n >= 576) return -1; const int h = n / 96, p = n % 96; if (p < 64) return n; const int q = p - 64; return h * 96 + 64 + ((q & 1) ? 16 + (q >> 1) : (q >> 1)); }
    return n;
}
__device__ __forceinline__ void transpose_item(const float* W, int K, int Nsrc, int Ndst, const float* g, int kind, bf16_t* WT, LAS float* scr, int item, int lane) {
    const int nblk = Ndst / 32, kb = item / nblk, nb = item % nblk, k0 = 64 * kb, n0 = 32 * nb;
    const int sc = src_col(kind, n0 + (lane & 31));
#pragma unroll 8
    for (int i = 0; i < 32; ++i) { const int kk = 2 * i + (lane >> 5);
        float v = 0.f; if (sc >= 0) { v = W[(size_t)(k0 + kk) * Nsrc + sc]; if (g) v *= g[k0 + kk]; }
        scr[kk * 33 + (lane & 31)] = v; }
    asm volatile("s_waitcnt lgkmcnt(0)" ::: "memory");
    const int c = lane & 7;
#pragma unroll
    for (int j = 0; j < 4; ++j) { const int n = (lane >> 3) + 8 * j; const LAS float* s = scr + (8 * c) * 33 + n;
        u32x4 o; o.x = pg8::cvt_pk_bf16(s[0 * 33], s[1 * 33]); o.y = pg8::cvt_pk_bf16(s[2 * 33], s[3 * 33]); o.z = pg8::cvt_pk_bf16(s[4 * 33], s[5 * 33]); o.w = pg8::cvt_pk_bf16(s[6 * 33], s[7 * 33]);
        *(u32x4*)(WT + (size_t)(n0 + n) * K + k0 + 8 * c) = o; }
    asm volatile("s_waitcnt lgkmcnt(0)" ::: "memory");
}

struct Params { const float* in[14]; float* out; unsigned char* ws; float inv64[32]; float inv32[16]; };

__global__ void __launch_bounds__(512, 2) hybrid_fwd(Params p) {
    extern __shared__ __attribute__((aligned(16))) unsigned char lds_raw[];
    LAS unsigned char* lds = (LAS unsigned char*)lds_raw;
    cg::grid_group grid = cg::this_grid();
#define WSP(name) unsigned char* name = p.ws; asm volatile("" : "+s"(name)); int bx = blockIdx.x; asm volatile("" : "+s"(bx)); int G = gridDim.x; asm volatile("" : "+s"(G))
#define PTR(T, v, off) T* v = (T*)(ws + (off))
    {
        WSP(ws); const float* x = p.in[0];
        PTR(float, cos64, WS_COS64); PTR(float, sin64, WS_SIN64); PTR(float, cos32, WS_COS32); PTR(float, sin32, WS_SIN32); PTR(float, SS1, WS_SS1); PTR(float, LAM, WS_LAM); PTR(bf16_t, XB, WS_XB);
        int tid = threadIdx.x; asm volatile("" : "+v"(tid)); const int lane = tid & 63, wave = __builtin_amdgcn_readfirstlane(tid >> 6);
        LAS float* scr = (LAS float*)(lds + wave * 16384);
        const int gw = bx * 8 + wave, NGW = G * 8;
        constexpr int I_IN = 16 * 80, I_UQ = 6 * 24, I_UKV = 2 * 24, I_O = 16 * 32, I_UP = 16 * 128, I_DN = 64 * 32, I_L = I_IN + I_UQ + I_UKV + I_O + I_UP + I_DN;
        for (int it = gw; it < 2 * I_L; it += NGW) {
            const int L = it / I_L; int r = it % I_L;
            unsigned char* wl = ws + WS_W + (size_t)L * W_LAYER;
            if (r < I_IN) { transpose_item(p.in[2] + (size_t)L * 1024 * 2464, 1024, 2464, NIN, p.in[1] + L * 1024, 0, (bf16_t*)(wl + W_IN), scr, r, lane); continue; } r -= I_IN;
            if (r < I_UQ) { transpose_item(p.in[4] + (size_t)L * 384 * 576, 384, 576, 768, p.in[3] + L * 384, 1, (bf16_t*)(wl + W_UQ), scr, r, lane); continue; } r -= I_UQ;
            if (r < I_UKV) { transpose_item(p.in[6] + (size_t)L * 128 * 768, 128, 768, 768, p.in[5] + L * 128, 2, (bf16_t*)(wl + W_UKV), scr, r, lane); continue; } r -= I_UKV;
            if (r < I_O) { transpose_item(p.in[9] + (size_t)L * 1024 * 1024, 1024, 1024, 1024, nullptr, 2, (bf16_t*)(wl + W_O), scr, r, lane); continue; } r -= I_O;
            if (r < I_UP) { transpose_item(p.in[11] + (size_t)L * 1024 * 4096, 1024, 4096, 4096, p.in[10] + L * 1024, 2, (bf16_t*)(wl + W_UP), scr, r, lane); continue; } r -= I_UP;
            transpose_item(p.in[12] + (size_t)L * 4096 * 1024, 4096, 1024, 1024, nullptr, 2, (bf16_t*)(wl + W_DN), scr, r, lane);
        }
        for (int mrow = gw; mrow < M; mrow += NGW) {
            const f32x4* xr = (const f32x4*)(x + (size_t)mrow * DM) + lane;
            float s = 0.f;
#pragma unroll
            for (int j = 0; j < 4; ++j) { const f32x4 v = xr[64 * j]; s += (v[0] * v[0] + v[1] * v[1]) + (v[2] * v[2] + v[3] * v[3]);
                u32x2 w; w.x = pg8::cvt_pk_bf16(v[0], v[1]); w.y = pg8::cvt_pk_bf16(v[2], v[3]); *((u32x2*)(XB + (size_t)mrow * DM) + lane + 64 * j) = w; }
            s = wave_sum(s);
            if (lane < 16) SS1[(size_t)mrow * 16 + lane] = lane == 0 ? s : 0.f;
        }
        const int gt = bx * 512 + tid, NGT = G * 512;
        for (int i = gt; i < SEQ * 48; i += NGT) {
            const int t = i / 48, j = i % 48;
            const float inv = j < 32 ? p.inv64[j] : p.inv32[j - 32];
            const float ang = (float)t * inv;
            double f = (double)ang * 0.15915494309189535; f -= __builtin_rint(f);
            const float ff = (float)f, c = __builtin_amdgcn_cosf(ff), s = __builtin_amdgcn_sinf(ff);
            if (j < 32) { cos64[t * 32 + j] = c; sin64[t * 32 + j] = s; } else { cos32[t * 16 + j - 32] = c; sin32[t * 16 + j - 32] = s; }
        }
        if (bx == 0 && tid < 2) {
            const float* lp = p.in[7] + tid * 128; float s1 = 0.f, s2 = 0.f;
            for (int i = 0; i < 32; ++i) { s1 += lp[i] * lp[32 + i]; s2 += lp[64 + i] * lp[96 + i]; }
            const float li = 0.8f - 0.6f * expf(-0.3f * (float)tid);
            LAM[tid * 2] = expf(s1) - expf(s2) + li; LAM[tid * 2 + 1] = 1.f - li;
        }
    }
    grid.sync();

    for (int L = 0; L < 2; ++L) {
        {
            WSP(ws); unsigned char* wl = ws + WS_W + (size_t)L * W_LAYER;
            PTR(float, cos64, WS_COS64); PTR(float, sin64, WS_SIN64); PTR(float, cos32, WS_COS32); PTR(float, sin32, WS_SIN32); PTR(float, SS1, WS_SS1); PTR(bf16_t, XB, WS_XB); PTR(bf16_t, Pb, WS_P);
            pg8::Gemm g{XB, (const bf16_t*)(wl + W_IN), M, NIN, 1024, 1024}; pg8::StaticOrder S; S.init(M, NIN, G, bx);
            EpiInProj E{Pb, cos64, sin64, cos32, sin32}; TabSS T{SS1};
            pg8::gemm_phase<EpiInProj, pg8::StaticOrder, TabSS, true, true>(lds, g, S, E, T);
        }
        grid.sync();
        {
            WSP(ws); unsigned char* wl = ws + WS_W + (size_t)L * W_LAYER; PTR(float, cos32, WS_COS32); PTR(float, sin32, WS_SIN32); PTR(bf16_t, Pb, WS_P); PTR(bf16_t, QB, WS_QB);
            pg8::Gemm g{Pb + 1152, (const bf16_t*)(wl + W_UQ), M, 768, 384, NIN}; pg8::StaticOrder S; S.init(M, 768, G, bx);
            EpiUq E{QB, cos32, sin32}; TabRows<384> T{Pb + 1152, NIN};
            pg8::gemm_phase<EpiUq, pg8::StaticOrder, TabRows<384>, true, true>(lds, g, S, E, T);
        }
        {
            WSP(ws); unsigned char* wl = ws + WS_W + (size_t)L * W_LAYER; PTR(bf16_t, Pb, WS_P); PTR(bf16_t, KVB, WS_KVB);
            pg8::Gemm g{Pb + 1536, (const bf16_t*)(wl + W_UKV), M, 768, 128, NIN}; pg8::StaticOrder S; S.init(M, 768, G, (bx + 192) % G);
            EpiScaled<0> E{KVB, 768}; TabRows<128> T{Pb + 1536, NIN};
            pg8::gemm_phase<EpiScaled<0>, pg8::StaticOrder, TabRows<128>, true, true>(lds, g, S, E, T);
        }
        grid.sync();
        {
            WSP(ws); PTR(bf16_t, Pb, WS_P); PTR(bf16_t, QB, WS_QB); PTR(bf16_t, KVB, WS_KVB); PTR(bf16_t, OA, WS_OA); PTR(float, LSE, WS_LSE); PTR(bf16_t, MIX, WS_MIX); PTR(float, LAM, WS_LAM); PTR(unsigned, ctl, WS_CTL);
            AttnBufs A{Pb, QB, KVB, OA, LSE, MIX, p.in[8] + L * 64, LAM[L * 2], LAM[L * 2 + 1]};
            attn_phase(lds, A, ctl + 64 * L);
        }
        grid.sync();
        {
            WSP(ws); PTR(bf16_t, OA, WS_OA); PTR(float, LSE, WS_LSE); PTR(bf16_t, MIX, WS_MIX);
            int gt = bx * 512 + threadIdx.x; asm volatile("" : "+v"(gt)); const int NGT = G * 512;
            for (int it = gt; it < M * 48; it += NGT) {
                const int row = it / 48, j = it % 48, h = j >> 3, ch = j & 7;
                const float l0 = LSE[(size_t)row * 8 + h], l1 = LSE[((size_t)M + row) * 8 + h], l2 = LSE[((size_t)2 * M + row) * 8 + h];
                const float mx = fmaxf(l0, fmaxf(l1, l2));
                float w0 = __builtin_amdgcn_exp2f(l0 - mx), w1 = __builtin_amdgcn_exp2f(l1 - mx), w2 = __builtin_amdgcn_exp2f(l2 - mx);
                const float inv = 1.f / (w0 + w1 + w2); w0 *= inv; w1 *= inv; w2 *= inv;
                const size_t o = (size_t)row * 384 + h * 64 + ch * 8;
                const u32x4 a = *(const u32x4*)(OA + o), b = *(const u32x4*)(OA + (size_t)M * 384 + o), c = *(const u32x4*)(OA + (size_t)2 * M * 384 + o);
                f32x4 v0, v1;
                v0[0] = w0 * bf_lo(a.x) + w1 * bf_lo(b.x) + w2 * bf_lo(c.x); v0[1] = w0 * bf_hi(a.x) + w1 * bf_hi(b.x) + w2 * bf_hi(c.x);
                v0[2] = w0 * bf_lo(a.y) + w1 * bf_lo(b.y) + w2 * bf_lo(c.y); v0[3] = w0 * bf_hi(a.y) + w1 * bf_hi(b.y) + w2 * bf_hi(c.y);
                v1[0] = w0 * bf_lo(a.z) + w1 * bf_lo(b.z) + w2 * bf_lo(c.z); v1[1] = w0 * bf_hi(a.z) + w1 * bf_hi(b.z) + w2 * bf_hi(c.z);
                v1[2] = w0 * bf_lo(a.w) + w1 * bf_lo(b.w) + w2 * bf_lo(c.w); v1[3] = w0 * bf_hi(a.w) + w1 * bf_hi(b.w) + w2 * bf_hi(c.w);
                *(u32x4*)(MIX + (size_t)row * DM + h * 64 + ch * 8) = pack8(v0, v1);
            }
        }
        grid.sync();
        {
            WSP(ws); unsigned char* wl = ws + WS_W + (size_t)L * W_LAYER; PTR(bf16_t, MIX, WS_MIX); PTR(bf16_t, XB, WS_XB); PTR(float, SS2, WS_SS2); const float* x = p.in[0]; float* out = p.out;
            pg8::Gemm g{MIX, (const bf16_t*)(wl + W_O), M, 1024, 1024, 1024}; pg8::StaticOrder S; S.init(M, 1024, G, bx);
            EpiResid E{L == 0 ? x : (const float*)out, out, XB, SS2}; TabNone T;
            pg8::gemm_phase<EpiResid, pg8::StaticOrder, TabNone, true, true>(lds, g, S, E, T);
        }
        grid.sync();
        {
            WSP(ws); unsigned char* wl = ws + WS_W + (size_t)L * W_LAYER; PTR(bf16_t, XB, WS_XB); PTR(bf16_t, HB, WS_H); PTR(float, SS2, WS_SS2);
            pg8::Gemm g{XB, (const bf16_t*)(wl + W_UP), M, FF, 1024, 1024}; pg8::StaticOrder S; S.init(M, FF, G, bx);
            EpiScaled<1> E{HB, FF}; TabSS T{SS2};
            pg8::gemm_phase<EpiScaled<1>, pg8::StaticOrder, TabSS, true, true>(lds, g, S, E, T);
        }
        grid.sync();
        {
            WSP(ws); unsigned char* wl = ws + WS_W + (size_t)L * W_LAYER; PTR(bf16_t, XB, WS_XB); PTR(bf16_t, HB, WS_H); PTR(float, SS1, WS_SS1); float* out = p.out;
            pg8::Gemm g{HB, (const bf16_t*)(wl + W_DN), M, 1024, FF, FF}; pg8::StaticOrder S; S.init(M, 1024, G, bx);
            EpiResid E{out, out, XB, SS1}; TabNone T;
            pg8::gemm_phase<EpiResid, pg8::StaticOrder, TabNone, true, true>(lds, g, S, E, T);
        }
        grid.sync();
    }
    {
        WSP(ws); PTR(float, SS1, WS_SS1); float* out = p.out;
        int tidf = threadIdx.x; asm volatile("" : "+v"(tidf)); const int lane = tidf & 63;
        const int gw = bx * 8 + (tidf >> 6), NGW = G * 8;
        const float* fg = p.in[13];
        for (int mrow = gw; mrow < M; mrow += NGW) {
            float s = lane < 16 ? SS1[(size_t)mrow * 16 + lane] : 0.f;
            s = wave_sum(s);
            const float rs = 1.f / sqrtf(s * (1.f / 1024.f) + EPS);
            f32x4* xr = (f32x4*)(out + (size_t)mrow * DM) + lane;
#pragma unroll
            for (int j = 0; j < 4; ++j) { const f32x4 gg = *((const f32x4*)fg + lane + 64 * j); f32x4 v = xr[64 * j]; v = v * rs * gg; xr[64 * j] = v; }
        }
    }
}

extern "C" void kernel_launch(void* const* d_in, const int* in_sizes, int n_in, void* d_out, int out_size, void* d_ws, size_t ws_size, hipStream_t stream) {
    static int grid = 0;
    if (grid == 0) {
        if (n_in != 14 || ws_size < WS_END) { fprintf(stderr, "kernel_launch: unexpected n_in %d / ws_size %zu\n", n_in, ws_size); grid = -1; return; }
        int dev = 0, cus = 0, per_cu = 0;
        hipGetDevice(&dev); hipDeviceGetAttribute(&cus, hipDeviceAttributeMultiprocessorCount, dev);
        if (hipFuncSetAttribute((const void*)hybrid_fwd, hipFuncAttributeMaxDynamicSharedMemorySize, LDS_BYTES) != hipSuccess) { fprintf(stderr, "kernel_launch: hipFuncSetAttribute failed\n"); grid = -1; return; }
        hipOccupancyMaxActiveBlocksPerMultiprocessor(&per_cu, (const void*)hybrid_fwd, 512, LDS_BYTES);
        if (per_cu < 1) per_cu = 1;
        grid = cus * 1;
        fprintf(stderr, "kernel_launch: cus %d per_cu %d grid %d ws %zu\n", cus, per_cu, grid, ws_size);
        (void)hipGetLastError();
    }
    if (grid < 0) return;
    hipMemsetAsync((char*)d_ws + WS_CTL, 0, 4096, stream);
    Params p{};
    for (int i = 0; i < 14; ++i) p.in[i] = (const float*)d_in[i];
    p.out = (float*)d_out; p.ws = (unsigned char*)d_ws;
    for (int i = 0; i < 32; ++i) p.inv64[i] = 1.0f / powf(10000.0f, (float)i / 32.0f);
    for (int i = 0; i < 16; ++i) p.inv32[i] = 1.0f / powf(10000.0f, (float)i / 16.0f);
    void* args[] = {&p};
    hipError_t e = hipLaunchCooperativeKernel((const void*)hybrid_fwd, dim3(grid), dim3(512), args, LDS_BYTES, stream);
    if (e != hipSuccess) fprintf(stderr, "cooperative launch failed: %s (grid %d)\n", hipGetErrorString(e), grid);
}
```

```cpp
#include <hip/hip_runtime.h>
#include <hip/hip_cooperative_groups.h>
#include <cstdio>
#include <cstdint>
#include <cmath>
namespace cg = cooperative_groups;

namespace pg8 {
#define PG8_LAS __attribute__((address_space(3)))
typedef unsigned short bf16_t;
typedef short bf16x8 __attribute__((ext_vector_type(8)));
typedef float f32x4 __attribute__((ext_vector_type(4)));
typedef unsigned u32x4 __attribute__((ext_vector_type(4)));
constexpr int BM = 256, BK = 64, HALF = 128, HTB = HALF * BK * 2  , STAGE_BYTES = 8 * HTB, NXCD = 8, WGM = 8;

__host__ __device__ __forceinline__ int lds_byte(int r, int c) { const int st = (r >> 4) * 2 + (c >> 5), rr = r & 15, cc = c & 31, ob = rr * 64 + cc * 2; return st * 1024 + (ob ^ (((ob >> 9) & 1) << 5)); }
__host__ __device__ __forceinline__ void stage_rc(int b, int& R, int& C) { const int st = b / 1024, sb = b % 1024, swz = sb ^ (((sb >> 9) & 1) << 5); R = (st >> 1) * 16 + swz / 64; C = (st & 1) * 32 + (swz % 64) / 2; }
__host__ __device__ __forceinline__ int perm32(int rho) { const int n = rho >> 4, i = rho & 15; return 8 * (i >> 2) + 4 * n + (i & 3); }

struct Unit { int pm, pn; };
struct Gemm { const bf16_t* A; const bf16_t* Bt; int M, N, K, lda; };

struct StaticOrder {
    int nM, nN, nwg, G, c;
    __host__ __device__ void init(int M, int N, int G_, int c_) { nM = M / BM; nN = N / BM; nwg = nM * nN; G = G_; c = c_; }
    __host__ __device__ bool next(int i, Unit& u) const {
        const long L = (long)i * G + c; if (L >= nwg) return false;
        int wgid = (int)L; { const int q = nwg / NXCD, r = nwg % NXCD, xcd = wgid % NXCD, off = wgid / NXCD; wgid = (xcd < r ? xcd * (q + 1) : r * (q + 1) + (xcd - r) * q) + off; }
        const int nig = WGM * nN, gid = wgid / nig, fm = gid * WGM, gsz = (nM - fm) < WGM ? (nM - fm) : WGM;
        u.pm = fm + ((wgid % nig) % gsz); u.pn = (wgid % nig) / gsz; return true;
    }
    __device__ __forceinline__ void a_ready(const Unit&) const {}
    __device__ __forceinline__ void done(const Unit&) const {}
};

__device__ __forceinline__ unsigned cvt_pk_bf16(float lo, float hi) { unsigned r; asm volatile("v_cvt_pk_bf16_f32 %0, %1, %2" : "=v"(r) : "v"(lo), "v"(hi)); return r; }
template <class Epi, class Sched, class Tab, bool ALIGN_EPI = false, bool SP2 = false>
__device__ __forceinline__ void gemm_phase(PG8_LAS unsigned char* lds, const Gemm g, const Sched& S, const Epi& E, const Tab& T) {
    int tid_ = threadIdx.x; asm volatile("" : "+v"(tid_));
    const int tid = tid_, wid = __builtin_amdgcn_readfirstlane(tid >> 6), lane = tid & 63, wr = wid >> 2, wc = wid & 3, fr = lane & 15, fq = lane >> 4;
    const int K = g.K, nt = K / BK;
    unsigned voffA[2], voffB[2];
#pragma unroll
    for (int i = 0; i < 2; ++i) { int R, C; stage_rc(tid * 16 + i * 8192, R, C); const int Rb = Epi::PERM ? ((R & ~31) + perm32(R & 31)) : R;
        voffA[i] = (unsigned)(R * g.lda + C) * 2u; voffB[i] = (unsigned)(Rb * K + C) * 2u; }
    const size_t kstep = (size_t)(BK * 2);
    const size_t hstepA = (size_t)HALF * g.lda * 2, hstepB = (size_t)HALF * K * 2;
    const size_t tstepA = 2 * hstepA, tstepB = 2 * hstepB;
    const unsigned ldsw = (unsigned)wid * 1024u;
    const int aoff = lds_byte(wr * 64 + fr, fq * 8), boff = lds_byte(wc * 32 + fr, fq * 8);
#define PG8_SA(b, h) (((b) * 2 + (h)) * HTB)
#define PG8_SB(b, h) ((4 + (b) * 2 + (h)) * HTB)
#define PG8_STAGE(bufoff, gbase, voff) do { _Pragma("unroll") for (int _i = 0; _i < 2; ++_i) \
        __builtin_amdgcn_global_load_lds((const unsigned*)((const char*)(gbase) + (voff)[_i]), (PG8_LAS unsigned*)(lds + (bufoff) + ldsw + _i * 8192), 16, 0, 0); } while (0)
#define PG8_LDA(dst, b, h) do { _Pragma("unroll") for (int m = 0; m < 4; ++m) _Pragma("unroll") for (int k = 0; k < 2; ++k) dst[m][k] = *(const PG8_LAS bf16x8*)(lds + PG8_SA(b, h) + aoff + m * 2048 + k * 1024); } while (0)
#define PG8_LDB(dst, b, h) do { _Pragma("unroll") for (int n = 0; n < 2; ++n) _Pragma("unroll") for (int k = 0; k < 2; ++k) dst[n][k] = *(const PG8_LAS bf16x8*)(lds + PG8_SB(b, h) + boff + n * 2048 + k * 1024); } while (0)
#define PG8_MMA(ai, bj, At, Bt) do { __builtin_amdgcn_s_setprio(1); _Pragma("unroll") for (int m = 0; m < 4; ++m) _Pragma("unroll") for (int n = 0; n < 2; ++n) _Pragma("unroll") for (int k = 0; k < 2; ++k) \
        acc[ai][bj][m][n] = __builtin_amdgcn_mfma_f32_16x16x32_bf16(Bt[n][k], At[m][k], acc[ai][bj][m][n], 0, 0, 0); __builtin_amdgcn_s_setprio(0); } while (0)
#define PG8_WAIT_V(n) asm volatile("s_waitcnt vmcnt(" #n ")" ::: "memory")
#define PG8_WAIT_L(n) asm volatile("s_waitcnt lgkmcnt(" #n ")" ::: "memory")
#define PG8_BAR __builtin_amdgcn_s_barrier()
#define PG8_SCHED __builtin_amdgcn_sched_barrier(0)
    Unit cur, nxt; int ui = 0;
    if (!S.next(0, cur)) return;
    f32x4 acc[2][2][4][2];
#pragma unroll
    for (int a = 0; a < 2; ++a)
#pragma unroll
        for (int b = 0; b < 2; ++b)
#pragma unroll
            for (int m = 0; m < 4; ++m)
#pragma unroll
                for (int n = 0; n < 2; ++n) acc[a][b][m][n] = (f32x4){0.f, 0.f, 0.f, 0.f};
    bf16x8 At[4][2], B0[2][2], B1[2][2];
    const char* cA = (const char*)g.A + (size_t)cur.pm * tstepA; const char* cB = (const char*)g.Bt + (size_t)cur.pn * tstepB;
    T.fill(cur, (PG8_LAS float*)(lds + STAGE_BYTES));
    if constexpr (SP2) {
        PG8_STAGE(PG8_SB(0, 0), cB, voffB); PG8_STAGE(PG8_SB(0, 1), cB + hstepB, voffB); PG8_STAGE(PG8_SA(0, 0), cA, voffA); PG8_STAGE(PG8_SA(0, 1), cA + hstepA, voffA);
        if (wr == 1) PG8_BAR;
        PG8_WAIT_V(2); PG8_BAR;
        PG8_STAGE(PG8_SB(1, 0), cB + kstep, voffB); PG8_STAGE(PG8_SA(1, 0), cA + kstep, voffA); PG8_STAGE(PG8_SB(1, 1), cB + hstepB + kstep, voffB);
        PG8_WAIT_V(6); PG8_BAR;
    } else {
        PG8_STAGE(PG8_SB(0, 0), cB, voffB); PG8_STAGE(PG8_SA(0, 0), cA, voffA); PG8_STAGE(PG8_SB(0, 1), cB + hstepB, voffB); PG8_STAGE(PG8_SA(0, 1), cA + hstepA, voffA);
        if (wr == 1) PG8_BAR;
        PG8_WAIT_V(4); PG8_BAR;
        PG8_STAGE(PG8_SB(1, 0), cB + kstep, voffB); PG8_STAGE(PG8_SA(1, 0), cA + kstep, voffA); PG8_STAGE(PG8_SB(1, 1), cB + hstepB + kstep, voffB);
        PG8_WAIT_V(6); PG8_BAR;
    }
    for (;;) {
        const bool has_next = S.next(ui + 1, nxt);
        const char* nA = has_next ? (const char*)g.A + (size_t)nxt.pm * tstepA : cA; const char* nB = has_next ? (const char*)g.Bt + (size_t)nxt.pn * tstepB : cB;
        for (int t = 0; t < nt; t += 2) {
            const bool last = (t == nt - 2);
            const char* a1 = cA + (size_t)(t + 1) * kstep;
            const char* a2 = last ? nA : cA + (size_t)(t + 2) * kstep; const char* b2 = last ? nB : cB + (size_t)(t + 2) * kstep;
            const char* a3 = a2 + kstep; const char* b3 = b2 + kstep;
            if (last && has_next) T.fill(nxt, (PG8_LAS float*)(lds + STAGE_BYTES + ((ui + 1) & 1) * 1024));
            if constexpr (SP2) {
            PG8_LDB(B0, 0, 0); PG8_LDB(B1, 0, 1); PG8_SCHED; PG8_LDA(At, 0, 0); PG8_STAGE(PG8_SA(1, 1), a1 + hstepA, voffA);
            PG8_WAIT_V(8); PG8_WAIT_L(0); PG8_BAR; PG8_MMA(0, 0, At, B0); PG8_MMA(0, 1, At, B1); PG8_BAR; PG8_SCHED;
            PG8_LDA(At, 0, 1); PG8_STAGE(PG8_SB(0, 0), b2, voffB); PG8_STAGE(PG8_SB(0, 1), b2 + hstepB, voffB); PG8_STAGE(PG8_SA(0, 0), a2, voffA);
            PG8_WAIT_V(8); PG8_WAIT_L(0); PG8_BAR; PG8_MMA(1, 0, At, B0); PG8_MMA(1, 1, At, B1); PG8_BAR; PG8_SCHED;
            PG8_LDB(B0, 1, 0); PG8_LDB(B1, 1, 1); PG8_SCHED; PG8_LDA(At, 1, 0); PG8_STAGE(PG8_SA(0, 1), a2 + hstepA, voffA);
            PG8_WAIT_V(8); PG8_WAIT_L(0); PG8_BAR; PG8_MMA(0, 0, At, B0); PG8_MMA(0, 1, At, B1); PG8_BAR; PG8_SCHED;
            PG8_LDA(At, 1, 1); PG8_STAGE(PG8_SB(1, 0), b3, voffB); PG8_STAGE(PG8_SB(1, 1), b3 + hstepB, voffB); PG8_STAGE(PG8_SA(1, 0), a3, voffA);
            PG8_WAIT_V(8); PG8_WAIT_L(0); PG8_BAR; PG8_MMA(1, 0, At, B0); PG8_MMA(1, 1, At, B1); PG8_BAR; PG8_SCHED;
            } else {
            PG8_LDB(B0, 0, 0); PG8_SCHED; PG8_LDA(At, 0, 0); PG8_STAGE(PG8_SA(1, 1), a1 + hstepA, voffA);
            PG8_WAIT_L(8); PG8_BAR; PG8_WAIT_L(0); PG8_MMA(0, 0, At, B0); PG8_BAR; PG8_SCHED;
            PG8_LDB(B1, 0, 1); PG8_STAGE(PG8_SB(0, 0), b2, voffB);
            PG8_BAR; PG8_WAIT_L(0); PG8_MMA(0, 1, At, B1); PG8_BAR;
            PG8_LDA(At, 0, 1); PG8_STAGE(PG8_SA(0, 0), a2, voffA);
            PG8_BAR; PG8_WAIT_L(0); PG8_MMA(1, 0, At, B0); PG8_BAR; PG8_SCHED;
            PG8_STAGE(PG8_SB(0, 1), b2 + hstepB, voffB);
            PG8_WAIT_V(6); PG8_BAR; PG8_MMA(1, 1, At, B1); PG8_BAR;
            PG8_LDB(B0, 1, 0); PG8_SCHED; PG8_LDA(At, 1, 0); PG8_STAGE(PG8_SA(0, 1), a2 + hstepA, voffA);
            PG8_WAIT_L(8); PG8_BAR; PG8_WAIT_L(0); PG8_MMA(0, 0, At, B0); PG8_BAR; PG8_SCHED;
            PG8_LDB(B1, 1, 1); PG8_STAGE(PG8_SB(1, 0), b3, voffB);
            PG8_BAR; PG8_WAIT_L(0); PG8_MMA(0, 1, At, B1); PG8_BAR;
            PG8_LDA(At, 1, 1); PG8_STAGE(PG8_SA(1, 0), a3, voffA);
            PG8_BAR; PG8_WAIT_L(0); PG8_MMA(1, 0, At, B0); PG8_BAR; PG8_SCHED;
            PG8_STAGE(PG8_SB(1, 1), b3 + hstepB, voffB);
            PG8_WAIT_V(6); PG8_BAR; PG8_MMA(1, 1, At, B1); PG8_BAR;
            }
        }
        if constexpr (ALIGN_EPI) { if (wr == 0) PG8_BAR; }
        E(acc, cur, wr, wc, fr, fq, (const PG8_LAS float*)(lds + STAGE_BYTES + (ui & 1) * 1024));
        if (!has_next) break;
#pragma unroll
        for (int a = 0; a < 2; ++a)
#pragma unroll
            for (int b = 0; b < 2; ++b)
#pragma unroll
                for (int m = 0; m < 4; ++m)
#pragma unroll
                    for (int n = 0; n < 2; ++n) acc[a][b][m][n] = (f32x4){0.f, 0.f, 0.f, 0.f};
        cur = nxt; cA = nA; cB = nB; ++ui;
        if constexpr (ALIGN_EPI) { if (wr == 1) PG8_BAR; }
    }
    PG8_WAIT_V(0);
    if constexpr (!ALIGN_EPI) { if (wr == 0) PG8_BAR; }
    PG8_BAR;
#undef PG8_SA
#undef PG8_SB
#undef PG8_STAGE
#undef PG8_LDA
#undef PG8_LDB
#undef PG8_MMA
#undef PG8_WAIT_V
#undef PG8_WAIT_L
#undef PG8_BAR
#undef PG8_SCHED
}
}

#define LAS __attribute__((address_space(3)))
typedef unsigned short bf16_t;
typedef short bf16x8 __attribute__((ext_vector_type(8)));
typedef float f32x4 __attribute__((ext_vector_type(4)));
typedef float f32x16 __attribute__((ext_vector_type(16)));
typedef unsigned u32x4 __attribute__((ext_vector_type(4)));
typedef unsigned u32x2 __attribute__((ext_vector_type(2)));

constexpr int BATCH = 2, SEQ = 8192, M = BATCH * SEQ, DM = 1024, NIN = 2560, FF = 4096;
constexpr float LOG2E = 1.4426950408889634f;
constexpr float SC_A = 0.125f * LOG2E, SC_B = 0.10206207261596575f * LOG2E, SC_C = 0.17677669529663687f * LOG2E;
constexpr float EPS = 1e-6f;

constexpr size_t MiB = 1u << 20;
constexpr size_t WS_CTL = 0;
constexpr size_t WS_COS64 = 1 * MiB, WS_SIN64 = 2 * MiB, WS_COS32 = 3 * MiB, WS_SIN32 = 3 * MiB + 512 * 1024;
constexpr size_t WS_SS1 = 4 * MiB, WS_SS2 = 5 * MiB, WS_LSE = 6 * MiB, WS_LAM = 7 * MiB + 512 * 1024;
constexpr size_t WS_W = 8 * MiB, W_LAYER = 24 * MiB;
constexpr size_t W_IN = 0, W_UQ = 5 * MiB, W_UKV = 5 * MiB + 768 * 1024, W_O = 6 * MiB, W_UP = 8 * MiB, W_DN = 16 * MiB;
constexpr size_t WS_XB = 56 * MiB, WS_OA = 56 * MiB, WS_MIX = 92 * MiB, WS_P = 124 * MiB, WS_QB = 204 * MiB, WS_KVB = 228 * MiB, WS_H = 124 * MiB, WS_END = 252 * MiB;
constexpr int LDS_BYTES = 147456;
constexpr int LDS_TAB = 131072, LDS_MISC = 131072 + 4096;

__device__ __forceinline__ float bf_lo(unsigned w) { return __uint_as_float(w << 16); }
__device__ __forceinline__ float bf_hi(unsigned w) { return __uint_as_float(w & 0xffff0000u); }
template <int PAT> __device__ __forceinline__ float swz(float v) { return __builtin_bit_cast(float, __builtin_amdgcn_ds_swizzle(__builtin_bit_cast(int, v), PAT)); }
__device__ __forceinline__ float xsum32(float v) { auto rr = __builtin_amdgcn_permlane32_swap(__float_as_uint(v), __float_as_uint(v), false, false); return __uint_as_float(rr[0]) + __uint_as_float(rr[1]); }
__device__ __forceinline__ u32x4 pack8(f32x4 a, f32x4 b) {
    u32x4 w; w.x = pg8::cvt_pk_bf16(a[0], a[1]); w.y = pg8::cvt_pk_bf16(a[2], a[3]); w.z = pg8::cvt_pk_bf16(b[0], b[1]); w.w = pg8::cvt_pk_bf16(b[2], b[3]); return w;
}
__device__ __forceinline__ void rope8(f32x4& a, f32x4& b, f32x4 cs, f32x4 sn) {
    float x, y;
    x = a[0]; y = a[1]; a[0] = x * cs[0] - y * sn[0]; a[1] = x * sn[0] + y * cs[0];
    x = a[2]; y = a[3]; a[2] = x * cs[1] - y * sn[1]; a[3] = x * sn[1] + y * cs[1];
    x = b[0]; y = b[1]; b[0] = x * cs[2] - y * sn[2]; b[1] = x * sn[2] + y * cs[2];
    x = b[2]; y = b[3]; b[2] = x * cs[3] - y * sn[3]; b[3] = x * sn[3] + y * cs[3];
}

struct TabNone { __device__ __forceinline__ void fill(const pg8::Unit&, LAS float*) const {} };
struct TabSS {
    const float* ss;
    __device__ __forceinline__ void fill(const pg8::Unit& u, LAS float* tab) const {
        int tid = threadIdx.x; asm volatile("" : "+v"(tid));
        if (tid < 256) {
            const f32x4* p = (const f32x4*)(ss + (size_t)(u.pm * 256 + tid) * 16);
            f32x4 s = p[0]; s = s + p[1]; s = s + p[2]; s = s + p[3];
            const float t = (s[0] + s[1]) + (s[2] + s[3]);
            tab[tid] = __builtin_amdgcn_rsqf(t * (1.f / 1024.f) + EPS);
        }
    }
};
template <int NCOLS> struct TabRows {
    const bf16_t* base; int pitch;
    __device__ __forceinline__ void fill(const pg8::Unit& u, LAS float* tab) const {
        int tid = threadIdx.x; asm volatile("" : "+v"(tid));
        const u32x4* p = (const u32x4*)(base + (size_t)(u.pm * 256 + (tid >> 1)) * pitch + (tid & 1) * (NCOLS / 2));
        float s = 0.f;
#pragma unroll 4
        for (int i = 0; i < NCOLS / 16; ++i) {
            const u32x4 v = p[i];
            s += bf_lo(v.x) * bf_lo(v.x) + bf_hi(v.x) * bf_hi(v.x) + bf_lo(v.y) * bf_lo(v.y) + bf_hi(v.y) * bf_hi(v.y)
               + bf_lo(v.z) * bf_lo(v.z) + bf_hi(v.z) * bf_hi(v.z) + bf_lo(v.w) * bf_lo(v.w) + bf_hi(v.w) * bf_hi(v.w);
        }
        s += swz<0x041f>(s);
        if (!(tid & 1)) tab[tid >> 1] = __builtin_amdgcn_rsqf(s * (1.f / NCOLS) + EPS);
    }
};

#define EPI_ROWS_BEGIN _Pragma("unroll") for (int ai = 0; ai < 2; ++ai) _Pragma("unroll") for (int m = 0; m < 4; ++m) { const int rl = ai * 128 + wr * 64 + m * 16 + fr; const int row = u.pm * 256 + rl;
#define EPI_ROWS_END }

struct EpiInProj {
    static constexpr bool PERM = true;
    bf16_t* P; const float* c64; const float* s64; const float* c32; const float* s32; int pn0;
    __device__ __forceinline__ void operator()(const f32x4 (&acc)[2][2][4][2], const pg8::Unit& u, int wr, int wc, int fr, int fq, const LAS float* tab) const {
#pragma unroll
        for (int bj = 0; bj < 2; ++bj) {
            const int cb = (u.pn + pn0) * 256 + bj * 128 + wc * 32, c0 = cb + 8 * fq;
            int typ = 0; float sc = 1.f;
            if (cb < 384) { typ = 1; sc = SC_A; } else if (cb < 768) typ = 1; else if (cb < 1664) typ = 0; else if (cb < 1696) typ = 2;
            else if (cb < 1792) typ = 0; else if (cb < 2048) { typ = 2; sc = SC_C; } else if (cb < 2304) typ = 2;
            EPI_ROWS_BEGIN
                const float rs = tab[rl] * sc;
                f32x4 v0 = acc[ai][bj][m][0] * rs, v1 = acc[ai][bj][m][1] * rs;
                if (typ == 1) { const int o = (row & (SEQ - 1)) * 32 + ((c0 & 63) >> 1); rope8(v0, v1, *(const f32x4*)(c64 + o), *(const f32x4*)(s64 + o)); }
                else if (typ == 2) { const int o = (row & (SEQ - 1)) * 16 + ((c0 & 31) >> 1); rope8(v0, v1, *(const f32x4*)(c32 + o), *(const f32x4*)(s32 + o)); }
                *(u32x4*)(P + (size_t)row * NIN + c0) = pack8(v0, v1);
            EPI_ROWS_END
        }
    }
};
struct EpiUq {
    static constexpr bool PERM = true;
    bf16_t* Q; const float* c32; const float* s32;
    __device__ __forceinline__ void operator()(const f32x4 (&acc)[2][2][4][2], const pg8::Unit& u, int wr, int wc, int fr, int fq, const LAS float* tab) const {
#pragma unroll
        for (int bj = 0; bj < 2; ++bj) {
            const int c0 = u.pn * 256 + bj * 128 + wc * 32 + 8 * fq;
            const bool ok = c0 < 576; const int h = c0 / 96, p = c0 - 96 * h; const bool rp = ok && p >= 64; const int i0 = rp ? ((p - 64) >> 1) : 0;
            EPI_ROWS_BEGIN
                const float rs = tab[rl] * SC_B;
                f32x4 v0 = acc[ai][bj][m][0] * rs, v1 = acc[ai][bj][m][1] * rs;
                const int o = (row & (SEQ - 1)) * 16 + i0;
                f32x4 cs = *(const f32x4*)(c32 + o), sn = *(const f32x4*)(s32 + o);
                if (!rp) { cs = (f32x4){1.f, 1.f, 1.f, 1.f}; sn = (f32x4){0.f, 0.f, 0.f, 0.f}; }
                rope8(v0, v1, cs, sn);
                if (ok) *(u32x4*)(Q + (size_t)row * 768 + c0) = pack8(v0, v1);
            EPI_ROWS_END
        }
    }
};
template <int ACT  > struct EpiScaled {
    static constexpr bool PERM = true;
    bf16_t* O; int ldc;
    __device__ __forceinline__ void operator()(const f32x4 (&acc)[2][2][4][2], const pg8::Unit& u, int wr, int wc, int fr, int fq, const LAS float* tab) const {
        EPI_ROWS_BEGIN
            const float rs = tab[rl];
#pragma unroll
            for (int bj = 0; bj < 2; ++bj) {
                const int c0 = u.pn * 256 + bj * 128 + wc * 32 + 8 * fq;
                f32x4 v0 = acc[ai][bj][m][0] * rs, v1 = acc[ai][bj][m][1] * rs;
                if (ACT == 1) {
#pragma unroll
                    for (int k = 0; k < 4; ++k) { const float a = fmaxf(v0[k], 0.f), b = fmaxf(v1[k], 0.f); v0[k] = a * a; v1[k] = b * b; }
                }
                *(u32x4*)(O + (size_t)row * ldc + c0) = pack8(v0, v1);
            }
        EPI_ROWS_END
    }
};
struct EpiResid {
    static constexpr bool PERM = true;
    const float* xin; float* xout; bf16_t* xb; float* ss;
    __device__ __forceinline__ void operator()(const f32x4 (&acc)[2][2][4][2], const pg8::Unit& u, int wr, int wc, int fr, int fq, const LAS float*) const {
        EPI_ROWS_BEGIN
            float sq = 0.f;
#pragma unroll
            for (int bj = 0; bj < 2; ++bj) {
                const size_t off = (size_t)row * DM + u.pn * 256 + bj * 128 + wc * 32 + 8 * fq;
                const f32x4 r0 = *(const f32x4*)(xin + off), r1 = *(const f32x4*)(xin + off + 4);
                const f32x4 v0 = r0 + acc[ai][bj][m][0], v1 = r1 + acc[ai][bj][m][1];
                *(f32x4*)(xout + off) = v0; *(f32x4*)(xout + off + 4) = v1;
                *(u32x4*)(xb + off) = pack8(v0, v1);
                sq += (v0[0] * v0[0] + v0[1] * v0[1]) + (v0[2] * v0[2] + v0[3] * v0[3]) + (v1[0] * v1[0] + v1[1] * v1[1]) + (v1[2] * v1[2] + v1[3] * v1[3]);
            }
            sq += swz<0x401f>(sq); sq = xsum32(sq);
            if (fq == 0) ss[(size_t)row * 16 + u.pn * 4 + wc] = sq;
        EPI_ROWS_END
    }
};

struct AttnBufs { const bf16_t* P; const bf16_t* QB; const bf16_t* KVB; bf16_t* OA; float* LSE; bf16_t* MIX; const float* subg; float lam; float oml; };
namespace att {
constexpr int KSTR = 1040, VOFF = 12544, VDH = 4160, BUFB = 20992, OST = 3 * BUFB, OSTW = 4608;
constexpr float NEG = -1e30f;
typedef short v4i16_t __attribute__((ext_vector_type(4)));
__device__ __forceinline__ int crow(int r, int hi) { return (r & 3) + 8 * (r >> 2) + 4 * hi; }
__device__ __forceinline__ v4i16_t vtr(const LAS unsigned char* p) { return __builtin_amdgcn_ds_read_tr16_b64_v4i16((LAS v4i16_t*)p); }
__device__ __forceinline__ float swapmax(float v) { auto rr = __builtin_amdgcn_permlane32_swap(__float_as_uint(v), __float_as_uint(v), false, false); return fmaxf(__uint_as_float(rr[0]), __uint_as_float(rr[1])); }
__device__ __forceinline__ float swapsum(float v) { auto rr = __builtin_amdgcn_permlane32_swap(__float_as_uint(v), __float_as_uint(v), false, false); return __uint_as_float(rr[0]) + __uint_as_float(rr[1]); }

__device__ __forceinline__ float max3f(float a, float b, float c) { float r; asm("v_max3_f32 %0, %1, %2, %3" : "=v"(r) : "v"(a), "v"(b), "v"(c)); return r; }
template <int TYPE, int DQ, int NMAP, int NQF, int NDS, bool BAND, int MPSEL>
__device__ __forceinline__ void att_qksm(const LAS unsigned char* Kb, const int kt, const int qw0, const int r32, const int hi, const int kofs,
                                         const bf16x8 (&qf)[NQF], f32x16 (&o)[NMAP][2], float (&mref)[NMAP], float (&lrun)[NMAP], f32x16 (&negm)[NMAP], const bool first, u32x4 (&pw)[NMAP][4]) {
    const int kmin = 64 * kt, kmax = kmin + 63;
    {
        bool needmask = kmax > qw0; if (BAND) needmask = needmask || (kmin + 128 < qw0 + 31);
#pragma unroll
        for (int mp = 0; mp < NMAP; ++mp) {
            if (MPSEL >= 0 && mp != MPSEL) continue;
            f32x16 s0, s1;
            if (NMAP == 1) { s0 = negm[mp]; s1 = negm[mp]; }
            else {
#pragma unroll
                for (int r = 0; r < 16; ++r) { s0[r] = -mref[mp]; s1[r] = s0[r]; }
            }
            constexpr int KH = NDS >= 4 ? NDS / 2 : NDS;
#pragma unroll
            for (int d1 = 0; d1 < NDS; d1 += KH) {
                bf16x8 kf0[KH], kf1[KH];
#pragma unroll
                for (int ds = 0; ds < KH; ++ds) {
                    kf0[ds] = *(const LAS bf16x8*)(Kb + kofs + (2 * (mp * NDS + d1 + ds)) * KSTR);
                    kf1[ds] = *(const LAS bf16x8*)(Kb + kofs + (2 * (mp * NDS + d1 + ds)) * KSTR + 512);
                }
                asm volatile("" ::: "memory");
#pragma unroll
                for (int ds = 0; ds < KH; ++ds) {
                    s0 = __builtin_amdgcn_mfma_f32_32x32x16_bf16(kf0[ds], qf[mp * NDS + d1 + ds], s0, 0, 0, 0);
                    s1 = __builtin_amdgcn_mfma_f32_32x32x16_bf16(kf1[ds], qf[mp * NDS + d1 + ds], s1, 0, 0, 0);
                }
            }
            if (needmask) {
                const int qpos = qw0 + r32;
#pragma unroll
                for (int r = 0; r < 16; ++r) {
                    const int kv0 = kmin + crow(r, hi), kv1 = kv0 + 32;
                    bool ok0 = kv0 <= qpos, ok1 = kv1 <= qpos;
                    if (BAND) { ok0 = ok0 && (kv0 + 128 >= qpos); ok1 = ok1 && (kv1 + 128 >= qpos); }
                    s0[r] = ok0 ? s0[r] : NEG; s1[r] = ok1 ? s1[r] : NEG;
                }
            }
            float ra = max3f(s0[0], s0[1], s1[0]), rb = max3f(s0[2], s0[3], s1[1]); ra = max3f(ra, s1[2], s1[3]);
#pragma unroll
            for (int r = 4; r < 16; r += 4) { ra = max3f(ra, s0[r], s0[r + 1]); rb = max3f(rb, s0[r + 2], s0[r + 3]); ra = max3f(ra, s1[r], s1[r + 1]); rb = max3f(rb, s1[r + 2], s1[r + 3]); }
            const float rm = swapmax(fmaxf(ra, rb));
            const float dl = first ? (rm > -1e29f ? rm : 0.f) : (rm > 8.f ? rm : 0.f);
            if (__any(dl != 0.f)) {
                mref[mp] += dl;
                const float f = __builtin_amdgcn_exp2f(-dl);
                lrun[mp] *= f;
#pragma unroll
                for (int r = 0; r < 16; ++r) { s0[r] -= dl; s1[r] -= dl; o[mp][0][r] *= f; o[mp][1][r] *= f; if (NMAP == 1) negm[mp][r] = -mref[mp]; }
            }
            float ps0 = 0.f, ps1 = 0.f;
#pragma unroll
            for (int r = 0; r < 16; ++r) { s0[r] = __builtin_amdgcn_exp2f(s0[r]); s1[r] = __builtin_amdgcn_exp2f(s1[r]); ps0 += s0[r]; ps1 += s1[r]; }
            lrun[mp] += ps0 + ps1;
#pragma unroll
            for (int k = 0; k < 2; ++k) {
                pw[mp][k]     = (u32x4){pg8::cvt_pk_bf16(s0[8 * k], s0[8 * k + 1]), pg8::cvt_pk_bf16(s0[8 * k + 2], s0[8 * k + 3]), pg8::cvt_pk_bf16(s0[8 * k + 4], s0[8 * k + 5]), pg8::cvt_pk_bf16(s0[8 * k + 6], s0[8 * k + 7])};
                pw[mp][2 + k] = (u32x4){pg8::cvt_pk_bf16(s1[8 * k], s1[8 * k + 1]), pg8::cvt_pk_bf16(s1[8 * k + 2], s1[8 * k + 3]), pg8::cvt_pk_bf16(s1[8 * k + 4], s1[8 * k + 5]), pg8::cvt_pk_bf16(s1[8 * k + 6], s1[8 * k + 7])};
            }
        }
    }
}
template <int NMAP, int MPSEL>
__device__ __forceinline__ void att_pv(const LAS unsigned char* Vb, f32x16 (&o)[NMAP][2], const u32x4 (&pw)[NMAP][4]) {
    constexpr int KB = 2;
#pragma unroll
    for (int kh = 0; kh < 4 / KB; ++kh) {
        v4i16_t vlo[KB][2], vhh[KB][2];
#pragma unroll
        for (int k2 = 0; k2 < KB; ++k2)
#pragma unroll
            for (int d0 = 0; d0 < 2; ++d0) { vlo[k2][d0] = vtr(Vb + d0 * VDH + (KB * kh + k2) * 1024); vhh[k2][d0] = vtr(Vb + d0 * VDH + (KB * kh + k2) * 1024 + 512); }
        asm volatile("" ::: "memory");
#pragma unroll
        for (int k2 = 0; k2 < KB; ++k2)
#pragma unroll
            for (int d0 = 0; d0 < 2; ++d0) {
                const bf16x8 vf = (bf16x8){vlo[k2][d0][0], vlo[k2][d0][1], vlo[k2][d0][2], vlo[k2][d0][3], vhh[k2][d0][0], vhh[k2][d0][1], vhh[k2][d0][2], vhh[k2][d0][3]};
#pragma unroll
                for (int mp = 0; mp < NMAP; ++mp) if (MPSEL < 0 || mp == MPSEL) o[mp][d0] = __builtin_amdgcn_mfma_f32_32x32x16_bf16(vf, __builtin_bit_cast(bf16x8, pw[mp][KB * kh + k2]), o[mp][d0], 0, 0, 0);
            }
    }
}

template <int TYPE>
__device__ __forceinline__ void attn_unit(LAS unsigned char* lds, const AttnBufs& A, int b, int h, int qb, int cfg, int res) {
    constexpr int DQ = TYPE == 0 ? 64 : (TYPE == 1 ? 96 : 32), NMAP = TYPE == 2 ? 2 : 1, NCH = NMAP * DQ / 8, NQF = NMAP * DQ / 16, NDS = DQ / 16;
    constexpr int NC1 = TYPE == 1 ? 8 : NCH, NKP = NCH * 64;
    constexpr bool BAND = TYPE == 0;
    int tid_ = threadIdx.x; asm volatile("" : "+v"(tid_));
    const int tid = tid_, lane = tid & 63, r32 = lane & 31, hi = lane >> 5;
    const int wid = __builtin_amdgcn_readfirstlane(tid >> 6);
    const int dil = (TYPE == 0) ? (cfg == 0 ? 1 : (cfg == 1 ? 4 : 16)) : 1;
    const long rowbase = (long)b * SEQ + res;
    const bf16_t *Qp, *K1p, *K2p, *Vp; int pQ, pK1, pK2, pV;
    if (TYPE == 0) { Qp = A.P + h * 64; pQ = NIN; K1p = A.P + 384 + h * 64; pK1 = NIN; K2p = K1p; pK2 = NIN; Vp = A.P + 768 + h * 64; pV = NIN; }
    else if (TYPE == 1) { Qp = A.QB + h * 96; pQ = 768; K1p = A.KVB + h * 128; pK1 = 768; K2p = A.P + 1664; pK2 = NIN; Vp = A.KVB + h * 128 + 64; pV = 768; }
    else { Qp = A.P + 1792 + h * 64; pQ = NIN; K1p = A.P + 2048 + h * 64; pK1 = NIN; K2p = K1p; pK2 = NIN; Vp = A.P + 2304 + h * 64; pV = NIN; }
    const int q0 = qb * 256, qw0 = q0 + wid * 32;
    const int kt_lo = BAND ? (qb > 0 ? 4 * qb - 2 : 0) : 0, kt_hi = 4 * qb + 4;
    bf16x8 qf[NQF];
    { const bf16_t* qrow = Qp + (rowbase + (long)dil * (qw0 + r32)) * pQ + hi * 8;
#pragma unroll
      for (int f = 0; f < NQF; ++f) qf[f] = *(const bf16x8*)(qrow + f * 16); }
    const bool k1ok = (NKP > 512) && (tid + 512 < NKP);
    const int p1 = k1ok ? tid + 512 : tid;
    const int krow0 = tid / NCH, kch0 = tid % NCH, krow1 = p1 / NCH, kch1 = p1 % NCH;
    const int vrow = tid >> 3, vch = tid & 7;
    const int kdst0 = kch0 * KSTR + krow0 * 16, kdst1 = kch1 * KSTR + krow1 * 16, vdst = VOFF + (vch >> 2) * VDH + vrow * 64 + (vch & 3) * 16;
    u32x4 kra0, kra1 = (u32x4){0u, 0u, 0u, 0u}, vra, krb0, krb1 = (u32x4){0u, 0u, 0u, 0u}, vrb;
    const char* kp0_; const char* kp1_; const char* vp_; long st0_, st1_, stv_;
    { const long g = rowbase + (long)dil * (64 * kt_lo + krow0);
      if (kch0 < NC1) { kp0_ = (const char*)(K1p + g * pK1 + kch0 * 8); st0_ = (long)dil * 64 * pK1 * 2; } else { kp0_ = (const char*)(K2p + g * pK2 + (kch0 - NC1) * 8); st0_ = (long)dil * 64 * pK2 * 2; } }
    { const long g = rowbase + (long)dil * (64 * kt_lo + krow1);
      if (kch1 < NC1) { kp1_ = (const char*)(K1p + g * pK1 + kch1 * 8); st1_ = (long)dil * 64 * pK1 * 2; } else { kp1_ = (const char*)(K2p + g * pK2 + (kch1 - NC1) * 8); st1_ = (long)dil * 64 * pK2 * 2; } }
    { const long g = rowbase + (long)dil * (64 * kt_lo + vrow); vp_ = (const char*)(Vp + g * pV + vch * 8); stv_ = (long)dil * 64 * pV * 2; }
#define ATT_LOADT(kt, kr0, kr1, vr) do { \
        kr0 = *(const u32x4*)kp0_; kp0_ += st0_; \
        if (NKP > 512) { kr1 = *(const u32x4*)kp1_; kp1_ += st1_; } \
        vr = *(const u32x4*)vp_; vp_ += stv_; } while (0)
#define ATT_STORET(bo, kr0, kr1, vr) do { *(LAS u32x4*)(lds + (bo) + kdst0) = kr0; if (k1ok) *(LAS u32x4*)(lds + (bo) + kdst1) = kr1; *(LAS u32x4*)(lds + (bo) + vdst) = vr; } while (0)
    f32x16 o[NMAP][2], negm[NMAP]; float mrun[NMAP], lrun[NMAP]; bool started = false;
#pragma unroll
    for (int mp = 0; mp < NMAP; ++mp) { mrun[mp] = 0.f; lrun[mp] = 0.f;
#pragma unroll
        for (int r = 0; r < 16; ++r) negm[mp][r] = 0.f;
#pragma unroll
        for (int d0 = 0; d0 < 2; ++d0)
#pragma unroll
            for (int r = 0; r < 16; ++r) o[mp][d0][r] = 0.f; }
    const int kofs = hi * KSTR + r32 * 16;
    const int vofs = VOFF + ((lane >> 4) & 1) * 32 + (lane & 3) * 8 + (4 * hi + ((lane & 15) >> 2)) * 64;
    const bool lag = (NMAP == 1) && wid >= 4;
    int bp = 0, bc = 0, bn = BUFB;
#define ATT_ROT() do { bp = bc; bc = bn; bn = (bn == 2 * BUFB) ? 0 : bn + BUFB; } while (0)
#define ATT_LOOP(STEP) \
    for (int kt = kt_lo; kt < kt_hi; kt += 2) {     \
        const bool more = kt + 2 < kt_hi; \
        const int ktn = more ? kt + 2 : kt;            \
        ATT_LOADT(ktn, kra0, kra1, vra); \
        STEP(kt); \
        ATT_STORET(bn, krb0, krb1, vrb); \
        __syncthreads(); \
        ATT_ROT(); \
        ATT_LOADT(ktn + 1, krb0, krb1, vrb); \
        STEP(kt + 1); \
        if (more) ATT_STORET(bn, kra0, kra1, vra); \
        __syncthreads(); \
        ATT_ROT(); \
    }
#define ATT_ACTIVE(kt_) ((64 * (kt_) <= qw0 + 31) && (!BAND || (64 * (kt_) + 63 + 128 >= qw0)))
#define ATT_QKSM(kt_, MP, pw_) att_qksm<TYPE, DQ, NMAP, NQF, NDS, BAND, MP>(lds + bc, (kt_), qw0, r32, hi, kofs, qf, o, mrun, lrun, negm, first_, pw_)
#define ATT_STEP_N(kt_) do { if (ATT_ACTIVE(kt_)) { const bool first_ = !started; started = true; u32x4 pw[NMAP][4]; \
            if (NMAP == 1) { ATT_QKSM(kt_, -1, pw); att_pv<NMAP, -1>(lds + bc + vofs, o, pw); } \
            else { ATT_QKSM(kt_, 0, pw); att_pv<NMAP, 0>(lds + bc + vofs, o, pw); ATT_QKSM(kt_, NMAP - 1, pw); att_pv<NMAP, NMAP - 1>(lds + bc + vofs, o, pw); } } } while (0)
#define ATT_STEP_L(kt_) do { if (pend) att_pv<NMAP, -1>(lds + bp + vofs, o, pwl); pend = false; \
        if (ATT_ACTIVE(kt_)) { const bool first_ = !started; started = true; ATT_QKSM(kt_, -1, pwl); pend = true; } } while (0)
    ATT_LOADT(kt_lo, kra0, kra1, vra); ATT_LOADT(kt_lo + 1, krb0, krb1, vrb); ATT_STORET(0, kra0, kra1, vra);
    __syncthreads();
    if (!lag) {
        ATT_LOOP(ATT_STEP_N)
    } else {
        u32x4 pwl[NMAP][4]; bool pend = false;
        ATT_LOOP(ATT_STEP_L)
        if (pend) att_pv<NMAP, -1>(lds + bp + vofs, o, pwl);
    }
    __syncthreads();
#undef ATT_STEP_N
#undef ATT_ACTIVE
#undef ATT_QKSM
#undef ATT_STEP_L
#undef ATT_LOOP
#undef ATT_ROT
#undef ATT_LOADT
#undef ATT_STORET
    float linv[NMAP], ltot[NMAP];
#pragma unroll
    for (int mp = 0; mp < NMAP; ++mp) { ltot[mp] = swapsum(lrun[mp]); linv[mp] = 1.f / ltot[mp]; }
    f32x16 val[2];
    if (TYPE == 2) {
        float sq = 0.f;
#pragma unroll
        for (int d0 = 0; d0 < 2; ++d0)
#pragma unroll
            for (int r = 0; r < 16; ++r) { const float v = o[0][d0][r] * linv[0] - A.lam * (o[NMAP - 1][d0][r] * linv[NMAP - 1]); val[d0][r] = v; sq += v * v; }
        sq = swapsum(sq);
        const float rs = __builtin_amdgcn_rsqf(sq * (1.f / 64.f) + 1e-5f) * A.oml;
#pragma unroll
        for (int d0 = 0; d0 < 2; ++d0)
#pragma unroll
            for (int g4 = 0; g4 < 4; ++g4) { const f32x4 gg = *(const f32x4*)(A.subg + 32 * d0 + 8 * g4 + 4 * hi);
#pragma unroll
                for (int k = 0; k < 4; ++k) val[d0][4 * g4 + k] *= rs * gg[k]; }
    } else {
#pragma unroll
        for (int d0 = 0; d0 < 2; ++d0)
#pragma unroll
            for (int r = 0; r < 16; ++r) val[d0][r] = o[0][d0][r] * linv[0];
    }
    LAS unsigned char* stg = lds + OST + wid * OSTW;
#pragma unroll
    for (int d0 = 0; d0 < 2; ++d0)
#pragma unroll
        for (int g4 = 0; g4 < 4; ++g4) {
            u32x2 w; w.x = pg8::cvt_pk_bf16(val[d0][4 * g4], val[d0][4 * g4 + 1]); w.y = pg8::cvt_pk_bf16(val[d0][4 * g4 + 2], val[d0][4 * g4 + 3]);
            *(LAS u32x2*)(stg + r32 * 144 + (32 * d0 + 8 * g4 + 4 * hi) * 2) = w;
        }
    bf16_t* Out; int pO;
    if (TYPE == 0) { Out = A.OA + (size_t)cfg * M * 384 + h * 64; pO = 384; }
    else if (TYPE == 1) { Out = A.MIX + 384 + h * 64; pO = DM; }
    else { Out = A.MIX + 768 + h * 64; pO = DM; }
#pragma unroll
    for (int i = 0; i < 4; ++i) {
        const int rr = 8 * i + (lane >> 3), ch = lane & 7;
        const u32x4 v = *(const LAS u32x4*)(stg + rr * 144 + ch * 16);
        *(u32x4*)(Out + (rowbase + (long)dil * (qw0 + rr)) * pO + ch * 8) = v;
    }
    if (TYPE == 0) { if (hi == 0) A.LSE[((size_t)cfg * M + rowbase + (long)dil * (qw0 + r32)) * 8 + h] = mrun[0] + __log2f(ltot[0]); }
}
}

constexpr int ATT_UNITS = 640 + 1152;
__device__ __forceinline__ void attn_phase(LAS unsigned char* lds, const AttnBufs& A, unsigned* ctr) {
    volatile LAS int* sh = (volatile LAS int*)(lds + LDS_MISC);
    for (;;) {
        if (threadIdx.x == 0) *sh = (int)atomicAdd(ctr, 1u);
        __syncthreads();
        const int idx = __builtin_amdgcn_readfirstlane(*sh);
        __syncthreads();
        if (idx >= ATT_UNITS) break;
        if (idx < 640) {
            const int qb = 31 - idx / 20, j = idx % 20;
            if (j < 12) att::attn_unit<1>(lds, A, j / 6, j % 6, qb, 0, 0);
            else att::attn_unit<2>(lds, A, (j - 12) / 4, (j - 12) % 4, qb, 0, 0);
        } else {
            const int a = idx - 640, cfg = a / 384, rem = a % 384, b = rem / 192, h = (rem / 32) % 6, tile = rem % 32;
            const int dl = cfg == 0 ? 1 : (cfg == 1 ? 4 : 16);
            att::attn_unit<0>(lds, A, b, h, tile / dl, cfg, tile % dl);
        }
    }
}

__device__ __forceinline__ float wave_sum(float v) {
    v += swz<0x041f>(v); v += swz<0x081f>(v); v += swz<0x101f>(v); v += swz<0x201f>(v); v += swz<0x401f>(v);
    return xsum32(v);
}
__device__ __forceinline__ int src_col(int kind, int n) {
    if (kind == 0) {
        if (n < 768) { const int blk = n >> 6, p = n & 63; return (blk << 6) + ((p & 1) ? 32 + (p >> 1) : (p >> 1)); }
        if (n < 1664) return n;
        if (n < 1696) { const int p = n - 1664; return 1664 + ((p & 1) ? 16 + (p >> 1) : (p >> 1)); }
        if (n < 1792) return -1;
        if (n < 2304) { const int q = n - 1792, blk = q >> 5, p = q & 31; return 1696 + (blk << 5) + ((p & 1) ? 16 + (p >> 1) : (p >> 1)); }
        return n - 96;
    }
    if (kind == 1) { if (n >= 576) return -1; const int h = n / 96, p = n % 96; if (p < 64) return n; const int q = p - 64; return h * 96 + 64 + ((q & 1) ? 16 + (q >> 1) : (q >> 1)); }
    return n;
}
__device__ __forceinline__ void transpose_item(const float* W, int K, int Nsrc, int Ndst, const float* g, int kind, bf16_t* WT, LAS float* scr, int item, int lane) {
    const int nblk = Ndst / 32, kb = item / nblk, nb = item % nblk, k0 = 64 * kb, n0 = 32 * nb;
    const int sc = src_col(kind, n0 + (lane & 31));
#pragma unroll
    for (int i = 0; i < 32; ++i) { const int kk = 2 * i + (lane >> 5);
        float v = 0.f; if (sc >= 0) { v = W[(size_t)(k0 + kk) * Nsrc + sc]; if (g) v *= g[k0 + kk]; }
        scr[kk * 33 + (lane & 31)] = v; }
    asm volatile("s_waitcnt lgkmcnt(0)" ::: "memory");
    const int c = lane & 7;
#pragma unroll
    for (int j = 0; j < 4; ++j) { const int n = (lane >> 3) + 8 * j; const LAS float* s = scr + (8 * c) * 33 + n;
        u32x4 o; o.x = pg8::cvt_pk_bf16(s[0 * 33], s[1 * 33]); o.y = pg8::cvt_pk_bf16(s[2 * 33], s[3 * 33]); o.z = pg8::cvt_pk_bf16(s[4 * 33], s[5 * 33]); o.w = pg8::cvt_pk_bf16(s[6 * 33], s[7 * 33]);
        *(u32x4*)(WT + (size_t)(n0 + n) * K + k0 + 8 * c) = o; }
    asm volatile("s_waitcnt lgkmcnt(0)" ::: "memory");
}

#define XB_TMO      128
#define XB_XCNT(j)  (256  + 64 * (j))
#define XB_XSUB(j)  (1280 + 64 * (j))
#define XB_XGEN(j)  (2304 + 64 * (j))
#define XB_TOP      3328
#define XB_TOPGEN   3392
#define XCD_BAR_WORDS 3456
#define XB_SPIN_CAP (1u << 18)

__device__ __forceinline__ unsigned xb_ld(unsigned* p)              { return __hip_atomic_load(p, __ATOMIC_RELAXED, __HIP_MEMORY_SCOPE_AGENT); }
__device__ __forceinline__ unsigned xb_add(unsigned* p, unsigned v) { return __hip_atomic_fetch_add(p, v, __ATOMIC_RELAXED, __HIP_MEMORY_SCOPE_AGENT); }
__device__ __forceinline__ unsigned xb_xcc_id() { return (unsigned)__builtin_amdgcn_s_getreg((3 << 11) | 20) & 0xFu; }
#define XB_SPIN(cond, bar) do { unsigned _sp = 0; while (cond) { __builtin_amdgcn_s_sleep(1); \
    if ((++_sp & 255u) == 0u) { if (xb_ld(&(bar)[XB_TMO])) break; if (_sp > XB_SPIN_CAP) { atomicAdd(&(bar)[XB_TMO], 1u); break; } } } } while (0)

struct XcdBarrier {
    unsigned* bar; unsigned x;
    volatile LAS unsigned* st;
};
__device__ __forceinline__ XcdBarrier xcd_barrier_post(unsigned* bar, volatile LAS unsigned* st) {
    XcdBarrier b; b.bar = bar; b.x = xb_xcc_id(); b.st = st;
    if (threadIdx.x == 0) (void)xb_add(&bar[XB_XCNT(b.x)], 1u);
    return b;
}
__device__ __forceinline__ void xcd_barrier_complete(unsigned* bar, unsigned x, unsigned& nloc, unsigned& nx) {
    const unsigned G = gridDim.x * gridDim.y * gridDim.z;
    unsigned sum, cnt, mine, sp = 0u;
    for (;;) {
        sum = 0u; cnt = 0u; mine = 0u;
#pragma unroll
        for (unsigned j = 0; j < 16; ++j) { const unsigned c = xb_ld(&bar[XB_XCNT(j)]); sum += c; cnt += (c > 0u) ? 1u : 0u; mine = (j == x) ? c : mine; }
        if (sum == G) break;
        __builtin_amdgcn_s_sleep(1);
        if ((++sp & 255u) == 0u) { if (xb_ld(&bar[XB_TMO])) break; if (sp > XB_SPIN_CAP) { atomicAdd(&bar[XB_TMO], 1u); break; } }
    }
    nloc = mine > 0u ? mine : 1u; nx = cnt > 0u ? cnt : 1u;
}

__device__ __forceinline__ void xcd_barrier(const XcdBarrier& b) {
    asm volatile("s_waitcnt vmcnt(0)" ::: "memory");
    __syncthreads();
    if (threadIdx.x == 0) {
        unsigned* bar = b.bar;
        __builtin_amdgcn_s_waitcnt(0);
        unsigned nloc = b.st[0], nx = b.st[1];
        if (nloc == 0u) { xcd_barrier_complete(bar, b.x, nloc, nx); b.st[0] = nloc; b.st[1] = nx; }
        const unsigned old = xb_add(&bar[XB_XSUB(b.x)], 1u);
        const unsigned gen = old / nloc;
        if (old + 1u == (gen + 1u) * nloc) {
            __builtin_amdgcn_fence(__ATOMIC_RELEASE, "agent");
            asm volatile("s_waitcnt vmcnt(0)" ::: "memory");
            const unsigned og = xb_add(&bar[XB_TOP], 1u);
            const unsigned tg = og / nx;
            if (og + 1u == (tg + 1u) * nx) xb_add(&bar[XB_TOPGEN], 1u);
            else XB_SPIN(xb_ld(&bar[XB_TOPGEN]) == tg, bar);
            __builtin_amdgcn_fence(__ATOMIC_ACQUIRE, "agent");
            xb_add(&bar[XB_XGEN(b.x)], 1u);
            asm volatile("s_waitcnt vmcnt(0)" ::: "memory");
        } else {
            XB_SPIN(xb_ld(&bar[XB_XGEN(b.x)]) == gen, bar);
            __builtin_amdgcn_fence(__ATOMIC_ACQUIRE, "agent");
            asm volatile("s_waitcnt vmcnt(0)" ::: "memory");
        }
    }
    __syncthreads();
}

struct Params { const float* in[14]; float* out; unsigned char* ws; float inv64[32]; float inv32[16]; };

__global__ void __launch_bounds__(512, 2) hybrid_fwd(Params p) {
    extern __shared__ __attribute__((aligned(16))) unsigned char lds_raw[];
    LAS unsigned char* lds = (LAS unsigned char*)lds_raw;
    cg::grid_group grid = cg::this_grid();
    if (threadIdx.x < 4) ((volatile LAS unsigned*)(lds + LDS_MISC + 64))[threadIdx.x] = 0u;
    __syncthreads();
    { XcdBarrier b0 = xcd_barrier_post((unsigned*)(p.ws + WS_CTL) + 1024, (volatile LAS unsigned*)(lds + LDS_MISC + 64)); (void)b0; }
#define GRID_BAR() do { XcdBarrier b_; b_.bar = (unsigned*)(p.ws + WS_CTL) + 1024; b_.x = xb_xcc_id(); b_.st = (volatile LAS unsigned*)(lds + LDS_MISC + 64); xcd_barrier(b_); } while (0)
#define WSP(name) size_t name##_off = 0; asm volatile("" : "+s"(name##_off)); unsigned char* name = p.ws + name##_off; int bx = blockIdx.x; asm volatile("" : "+s"(bx)); int G = gridDim.x; asm volatile("" : "+s"(G))
#define PTR(T, v, off) T* v = (T*)(ws + (off))
    grid.sync();
    {
        WSP(ws); const float* x = p.in[0];
        PTR(float, cos64, WS_COS64); PTR(float, sin64, WS_SIN64); PTR(float, cos32, WS_COS32); PTR(float, sin32, WS_SIN32); PTR(float, SS1, WS_SS1); PTR(float, LAM, WS_LAM); PTR(bf16_t, XB, WS_XB);
        int tid = threadIdx.x; asm volatile("" : "+v"(tid)); const int lane = tid & 63, wave = __builtin_amdgcn_readfirstlane(tid >> 6);
        LAS float* scr = (LAS float*)(lds + wave * 16384);
        const int gw = bx * 8 + wave, NGW = G * 8;
        constexpr int I_IN = 16 * 80, I_UQ = 6 * 24, I_UKV = 2 * 24, I_O = 16 * 32, I_UP = 16 * 128, I_DN = 64 * 32, I_L = I_IN + I_UQ + I_UKV + I_O + I_UP + I_DN;
        for (int it = gw; it < 2 * I_L; it += NGW) {
            const int L = it / I_L; int r = it % I_L;
            unsigned char* wl = ws + WS_W + (size_t)L * W_LAYER;
            if (r < I_IN) { transpose_item(p.in[2] + (size_t)L * 1024 * 2464, 1024, 2464, NIN, p.in[1] + L * 1024, 0, (bf16_t*)(wl + W_IN), scr, r, lane); continue; } r -= I_IN;
            if (r < I_UQ) { transpose_item(p.in[4] + (size_t)L * 384 * 576, 384, 576, 768, p.in[3] + L * 384, 1, (bf16_t*)(wl + W_UQ), scr, r, lane); continue; } r -= I_UQ;
            if (r < I_UKV) { transpose_item(p.in[6] + (size_t)L * 128 * 768, 128, 768, 768, p.in[5] + L * 128, 2, (bf16_t*)(wl + W_UKV), scr, r, lane); continue; } r -= I_UKV;
            if (r < I_O) { transpose_item(p.in[9] + (size_t)L * 1024 * 1024, 1024, 1024, 1024, nullptr, 2, (bf16_t*)(wl + W_O), scr, r, lane); continue; } r -= I_O;
            if (r < I_UP) { transpose_item(p.in[11] + (size_t)L * 1024 * 4096, 1024, 4096, 4096, p.in[10] + L * 1024, 2, (bf16_t*)(wl + W_UP), scr, r, lane); continue; } r -= I_UP;
            transpose_item(p.in[12] + (size_t)L * 4096 * 1024, 4096, 1024, 1024, nullptr, 2, (bf16_t*)(wl + W_DN), scr, r, lane);
        }
        for (int mrow = gw; mrow < M; mrow += NGW) {
            const f32x4* xr = (const f32x4*)(x + (size_t)mrow * DM) + lane;
            float s = 0.f;
#pragma unroll
            for (int j = 0; j < 4; ++j) { const f32x4 v = xr[64 * j]; s += (v[0] * v[0] + v[1] * v[1]) + (v[2] * v[2] + v[3] * v[3]);
                u32x2 w; w.x = pg8::cvt_pk_bf16(v[0], v[1]); w.y = pg8::cvt_pk_bf16(v[2], v[3]); *((u32x2*)(XB + (size_t)mrow * DM) + lane + 64 * j) = w; }
            s = wave_sum(s);
            if (lane < 16) SS1[(size_t)mrow * 16 + lane] = lane == 0 ? s : 0.f;
        }
        const int gt = bx * 512 + tid, NGT = G * 512;
        for (int i = gt; i < SEQ * 48; i += NGT) {
            const int t = i / 48, j = i % 48;
            const float inv = j < 32 ? p.inv64[j] : p.inv32[j - 32];
            const float ang = (float)t * inv;
            double f = (double)ang * 0.15915494309189535; f -= __builtin_rint(f);
            const float ff = (float)f, c = __builtin_amdgcn_cosf(ff), s = __builtin_amdgcn_sinf(ff);
            if (j < 32) { cos64[t * 32 + j] = c; sin64[t * 32 + j] = s; } else { cos32[t * 16 + j - 32] = c; sin32[t * 16 + j - 32] = s; }
        }
        if (bx == 0 && tid < 2) {
            const float* lp = p.in[7] + tid * 128; float s1 = 0.f, s2 = 0.f;
            for (int i = 0; i < 32; ++i) { s1 += lp[i] * lp[32 + i]; s2 += lp[64 + i] * lp[96 + i]; }
            const float li = 0.8f - 0.6f * expf(-0.3f * (float)tid);
            LAM[tid * 2] = expf(s1) - expf(s2) + li; LAM[tid * 2 + 1] = 1.f - li;
        }
    }
    GRID_BAR();

    for (int L = 0; L < 2; ++L) {
        {
            WSP(ws); unsigned char* wl = ws + WS_W + (size_t)L * W_LAYER;
            PTR(float, cos64, WS_COS64); PTR(float, sin64, WS_SIN64); PTR(float, cos32, WS_COS32); PTR(float, sin32, WS_SIN32); PTR(float, SS1, WS_SS1); PTR(bf16_t, XB, WS_XB); PTR(bf16_t, Pb, WS_P);
            pg8::Gemm g{XB, (const bf16_t*)(wl + W_IN), M, 2048, 1024, 1024}; pg8::StaticOrder S; S.init(M, 2048, G, bx);
            EpiInProj E{Pb, cos64, sin64, cos32, sin32, 0}; TabSS T{SS1};
            pg8::gemm_phase<EpiInProj, pg8::StaticOrder, TabSS, true, true>(lds, g, S, E, T);
        }
        GRID_BAR();
        {
            const int Gh = (int)gridDim.x / 2;
            {
                WSP(ws); unsigned char* wl = ws + WS_W + (size_t)L * W_LAYER;
                PTR(float, cos64, WS_COS64); PTR(float, sin64, WS_SIN64); PTR(float, cos32, WS_COS32); PTR(float, sin32, WS_SIN32); PTR(float, SS1, WS_SS1); PTR(bf16_t, XB, WS_XB); PTR(bf16_t, Pb, WS_P);
                pg8::Gemm g{XB, (const bf16_t*)(wl + W_IN) + (size_t)2048 * 1024, M, 512, 1024, 1024}; pg8::StaticOrder S; S.init(M, 512, Gh, bx < Gh ? bx : (1 << 28));
                EpiInProj E{Pb, cos64, sin64, cos32, sin32, 8}; TabSS T{SS1};
                pg8::gemm_phase<EpiInProj, pg8::StaticOrder, TabSS, true, true>(lds, g, S, E, T);
            }
            {
                WSP(ws); unsigned char* wl = ws + WS_W + (size_t)L * W_LAYER; PTR(float, cos32, WS_COS32); PTR(float, sin32, WS_SIN32); PTR(bf16_t, Pb, WS_P); PTR(bf16_t, QB, WS_QB);
                pg8::Gemm g{Pb + 1152, (const bf16_t*)(wl + W_UQ), M, 768, 384, NIN}; pg8::StaticOrder S; S.init(M, 768, Gh, bx >= Gh ? bx - Gh : (1 << 28));
                EpiUq E{QB, cos32, sin32}; TabRows<384> T{Pb + 1152, NIN};
                pg8::gemm_phase<EpiUq, pg8::StaticOrder, TabRows<384>, true, true>(lds, g, S, E, T);
            }
            {
                WSP(ws); unsigned char* wl = ws + WS_W + (size_t)L * W_LAYER; PTR(bf16_t, Pb, WS_P); PTR(bf16_t, KVB, WS_KVB);
                pg8::Gemm g{Pb + 1536, (const bf16_t*)(wl + W_UKV), M, 768, 128, NIN}; pg8::StaticOrder S; S.init(M, 768, Gh, bx >= Gh ? (bx - Gh + Gh / 2) % Gh : (1 << 28));
                EpiScaled<0> E{KVB, 768}; TabRows<128> T{Pb + 1536, NIN};
                pg8::gemm_phase<EpiScaled<0>, pg8::StaticOrder, TabRows<128>, true, true>(lds, g, S, E, T);
            }
        }
        GRID_BAR();
        {
            WSP(ws); PTR(bf16_t, Pb, WS_P); PTR(bf16_t, QB, WS_QB); PTR(bf16_t, KVB, WS_KVB); PTR(bf16_t, OA, WS_OA); PTR(float, LSE, WS_LSE); PTR(bf16_t, MIX, WS_MIX); PTR(float, LAM, WS_LAM); PTR(unsigned, ctl, WS_CTL);
            AttnBufs A{Pb, QB, KVB, OA, LSE, MIX, p.in[8] + L * 64, LAM[L * 2], LAM[L * 2 + 1]};
            attn_phase(lds, A, ctl + 64 * L);
        }
        GRID_BAR();
        {
            WSP(ws); PTR(bf16_t, OA, WS_OA); PTR(float, LSE, WS_LSE); PTR(bf16_t, MIX, WS_MIX);
            int gt = bx * 512 + threadIdx.x; asm volatile("" : "+v"(gt)); const int NGT = G * 512;
            for (int it = gt; it < M * 48; it += NGT) {
                const int row = it / 48, j = it % 48, h = j >> 3, ch = j & 7;
                const float l0 = LSE[(size_t)row * 8 + h], l1 = LSE[((size_t)M + row) * 8 + h], l2 = LSE[((size_t)2 * M + row) * 8 + h];
                const float mx = fmaxf(l0, fmaxf(l1, l2));
                float w0 = __builtin_amdgcn_exp2f(l0 - mx), w1 = __builtin_amdgcn_exp2f(l1 - mx), w2 = __builtin_amdgcn_exp2f(l2 - mx);
                const float inv = 1.f / (w0 + w1 + w2); w0 *= inv; w1 *= inv; w2 *= inv;
                const size_t o = (size_t)row * 384 + h * 64 + ch * 8;
                const u32x4 a = *(const u32x4*)(OA + o), b = *(const u32x4*)(OA + (size_t)M * 384 + o), c = *(const u32x4*)(OA + (size_t)2 * M * 384 + o);
                f32x4 v0, v1;
                v0[0] = w0 * bf_lo(a.x) + w1 * bf_lo(b.x) + w2 * bf_lo(c.x); v0[1] = w0 * bf_hi(a.x) + w1 * bf_hi(b.x) + w2 * bf_hi(c.x);
                v0[2] = w0 * bf_lo(a.y) + w1 * bf_lo(b.y) + w2 * bf_lo(c.y); v0[3] = w0 * bf_hi(a.y) + w1 * bf_hi(b.y) + w2 * bf_hi(c.y);
                v1[0] = w0 * bf_lo(a.z) + w1 * bf_lo(b.z) + w2 * bf_lo(c.z); v1[1] = w0 * bf_hi(a.z) + w1 * bf_hi(b.z) + w2 * bf_hi(c.z);
                v1[2] = w0 * bf_lo(a.w) + w1 * bf_lo(b.w) + w2 * bf_lo(c.w); v1[3] = w0 * bf_hi(a.w) + w1 * bf_hi(b.w) + w2 * bf_hi(c.w);
                *(u32x4*)(MIX + (size_t)row * DM + h * 64 + ch * 8) = pack8(v0, v1);
            }
        }
        GRID_BAR();
        {
            WSP(ws); unsigned char* wl = ws + WS_W + (size_t)L * W_LAYER; PTR(bf16_t, MIX, WS_MIX); PTR(bf16_t, XB, WS_XB); PTR(float, SS2, WS_SS2); const float* x = p.in[0]; float* out = p.out;
            pg8::Gemm g{MIX, (const bf16_t*)(wl + W_O), M, 1024, 1024, 1024}; pg8::StaticOrder S; S.init(M, 1024, G, bx);
            EpiResid E{L == 0 ? x : (const float*)out, out, XB, SS2}; TabNone T;
            pg8::gemm_phase<EpiResid, pg8::StaticOrder, TabNone, false, true>(lds, g, S, E, T);
        }
        GRID_BAR();
        {
            WSP(ws); unsigned char* wl = ws + WS_W + (size_t)L * W_LAYER; PTR(bf16_t, XB, WS_XB); PTR(bf16_t, HB, WS_H); PTR(float, SS2, WS_SS2);
            pg8::Gemm g{XB, (const bf16_t*)(wl + W_UP), M, FF, 1024, 1024}; pg8::StaticOrder S; S.init(M, FF, G, bx);
            EpiScaled<1> E{HB, FF}; TabSS T{SS2};
            pg8::gemm_phase<EpiScaled<1>, pg8::StaticOrder, TabSS, true, true>(lds, g, S, E, T);
        }
        GRID_BAR();
        {
            WSP(ws); unsigned char* wl = ws + WS_W + (size_t)L * W_LAYER; PTR(bf16_t, XB, WS_XB); PTR(bf16_t, HB, WS_H); PTR(float, SS1, WS_SS1); float* out = p.out;
            pg8::Gemm g{HB, (const bf16_t*)(wl + W_DN), M, 1024, FF, FF}; pg8::StaticOrder S; S.init(M, 1024, G, bx);
            EpiResid E{out, out, XB, SS1}; TabNone T;
            pg8::gemm_phase<EpiResid, pg8::StaticOrder, TabNone, false, true>(lds, g, S, E, T);
        }
        GRID_BAR();
    }
    {
        WSP(ws); PTR(float, SS1, WS_SS1); float* out = p.out;
        int tidf = threadIdx.x; asm volatile("" : "+v"(tidf)); const int lane = tidf & 63;
        const int gw = bx * 8 + (tidf >> 6), NGW = G * 8;
        const float* fg = p.in[13];
        for (int mrow = gw; mrow < M; mrow += NGW) {
            float s = lane < 16 ? SS1[(size_t)mrow * 16 + lane] : 0.f;
            s = wave_sum(s);
            const float rs = 1.f / sqrtf(s * (1.f / 1024.f) + EPS);
            f32x4* xr = (f32x4*)(out + (size_t)mrow * DM) + lane;
#pragma unroll
            for (int j = 0; j < 4; ++j) { const f32x4 gg = *((const f32x4*)fg + lane + 64 * j); f32x4 v = xr[64 * j]; v = v * rs * gg; xr[64 * j] = v; }
        }
    }
}

extern "C" void kernel_launch(void* const* d_in, const int* in_sizes, int n_in, void* d_out, int out_size, void* d_ws, size_t ws_size, hipStream_t stream) {
    static int grid = 0;
    if (grid == 0) {
        if (n_in != 14 || ws_size < WS_END) { fprintf(stderr, "kernel_launch: unexpected n_in %d / ws_size %zu\n", n_in, ws_size); grid = -1; return; }
        int dev = 0, cus = 0, per_cu = 0;
        hipGetDevice(&dev); hipDeviceGetAttribute(&cus, hipDeviceAttributeMultiprocessorCount, dev);
        if (hipFuncSetAttribute((const void*)hybrid_fwd, hipFuncAttributeMaxDynamicSharedMemorySize, LDS_BYTES) != hipSuccess) { fprintf(stderr, "kernel_launch: hipFuncSetAttribute failed\n"); grid = -1; return; }
        hipOccupancyMaxActiveBlocksPerMultiprocessor(&per_cu, (const void*)hybrid_fwd, 512, LDS_BYTES);
        if (per_cu < 1) per_cu = 1;
        grid = cus * 1;
        fprintf(stderr, "kernel_launch: cus %d per_cu %d grid %d ws %zu\n", cus, per_cu, grid, ws_size);
        (void)hipGetLastError();
    }
    if (grid < 0) return;
    hipMemsetAsync((char*)d_ws + WS_CTL, 0, 32768, stream);
    Params p{};
    for (int i = 0; i < 14; ++i) p.in[i] = (const float*)d_in[i];
    p.out = (float*)d_out; p.ws = (unsigned char*)d_ws;
    for (int i = 0; i < 32; ++i) p.inv64[i] = 1.0f / powf(10000.0f, (float)i / 32.0f);
    for (int i = 0; i < 16; ++i) p.inv32[i] = 1.0f / powf(10000.0f, (float)i / 16.0f);
    void* args[] = {&p};
    hipError_t e = hipLaunchCooperativeKernel((const void*)hybrid_fwd, dim3(grid), dim3(512), args, LDS_BYTES, stream);
    if (e != hipSuccess) fprintf(stderr, "cooperative launch failed: %s (grid %d)\n", hipGetErrorString(e), grid);
}
```

```cpp
#include <hip/hip_runtime.h>
#include <hip/hip_cooperative_groups.h>
#include <cstdio>
#include <cstdint>
#include <cmath>
namespace cg = cooperative_groups;

namespace pg8 {
#define PG8_LAS __attribute__((address_space(3)))
typedef unsigned short bf16_t;
typedef short bf16x8 __attribute__((ext_vector_type(8)));
typedef float f32x4 __attribute__((ext_vector_type(4)));
typedef unsigned u32x4 __attribute__((ext_vector_type(4)));
constexpr int BM = 256, BK = 64, HALF = 128, HTB = HALF * BK * 2  , STAGE_BYTES = 8 * HTB, NXCD = 8, WGM = 8;

__host__ __device__ __forceinline__ int lds_byte(int r, int c) { const int st = (r >> 4) * 2 + (c >> 5), rr = r & 15, cc = c & 31, ob = rr * 64 + cc * 2; return st * 1024 + (ob ^ (((ob >> 9) & 1) << 5)); }
__host__ __device__ __forceinline__ void stage_rc(int b, int& R, int& C) { const int st = b / 1024, sb = b % 1024, swz = sb ^ (((sb >> 9) & 1) << 5); R = (st >> 1) * 16 + swz / 64; C = (st & 1) * 32 + (swz % 64) / 2; }
__host__ __device__ __forceinline__ int perm32(int rho) { const int n = rho >> 4, i = rho & 15; return 8 * (i >> 2) + 4 * n + (i & 3); }

struct Unit { int pm, pn; };
struct Gemm { const bf16_t* A; const bf16_t* Bt; int M, N, K, lda; };

struct StaticOrder {
    int nM, nN, nwg, G, c;
    __host__ __device__ void init(int M, int N, int G_, int c_) { nM = M / BM; nN = N / BM; nwg = nM * nN; G = G_; c = c_; }
    __host__ __device__ bool next(int i, Unit& u) const {
        const long L = (long)i * G + c; if (L >= nwg) return false;
        int wgid = (int)L; { const int q = nwg / NXCD, r = nwg % NXCD, xcd = wgid % NXCD, off = wgid / NXCD; wgid = (xcd < r ? xcd * (q + 1) : r * (q + 1) + (xcd - r) * q) + off; }
        const int nig = WGM * nN, gid = wgid / nig, fm = gid * WGM, gsz = (nM - fm) < WGM ? (nM - fm) : WGM;
        u.pm = fm + ((wgid % nig) % gsz); u.pn = (wgid % nig) / gsz; return true;
    }
    __device__ __forceinline__ void a_ready(const Unit&) const {}
    __device__ __forceinline__ void done(const Unit&) const {}
};

__device__ __forceinline__ unsigned cvt_pk_bf16(float lo, float hi) { unsigned r; asm volatile("v_cvt_pk_bf16_f32 %0, %1, %2" : "=v"(r) : "v"(lo), "v"(hi)); return r; }
template <class Epi, class Sched, class Tab, bool ALIGN_EPI = false, bool SP2 = false>
__device__ __forceinline__ void gemm_phase(PG8_LAS unsigned char* lds, const Gemm g, const Sched& S, const Epi& E, const Tab& T) {
    int tid_ = threadIdx.x; asm volatile("" : "+v"(tid_));
    const int tid = tid_, wid = __builtin_amdgcn_readfirstlane(tid >> 6), lane = tid & 63, wr = wid >> 2, wc = wid & 3, fr = lane & 15, fq = lane >> 4;
    const int K = g.K, nt = K / BK;
    unsigned voffA[2], voffB[2];
#pragma unroll
    for (int i = 0; i < 2; ++i) { int R, C; stage_rc(tid * 16 + i * 8192, R, C); const int Rb = Epi::PERM ? ((R & ~31) + perm32(R & 31)) : R;
        voffA[i] = (unsigned)(R * g.lda + C) * 2u; voffB[i] = (unsigned)(Rb * K + C) * 2u; }
    const size_t kstep = (size_t)(BK * 2);
    const size_t hstepA = (size_t)HALF * g.lda * 2, hstepB = (size_t)HALF * K * 2;
    const size_t tstepA = 2 * hstepA, tstepB = 2 * hstepB;
    const unsigned ldsw = (unsigned)wid * 1024u;
    const int aoff = lds_byte(wr * 64 + fr, fq * 8), boff = lds_byte(wc * 32 + fr, fq * 8);
#define PG8_SA(b, h) (((b) * 2 + (h)) * HTB)
#define PG8_SB(b, h) ((4 + (b) * 2 + (h)) * HTB)
#define PG8_STAGE(bufoff, gbase, voff) do { _Pragma("unroll") for (int _i = 0; _i < 2; ++_i) \
        __builtin_amdgcn_global_load_lds((const unsigned*)((const char*)(gbase) + (voff)[_i]), (PG8_LAS unsigned*)(lds + (bufoff) + ldsw + _i * 8192), 16, 0, 0); } while (0)
#define PG8_LDA(dst, b, h) do { _Pragma("unroll") for (int m = 0; m < 4; ++m) _Pragma("unroll") for (int k = 0; k < 2; ++k) dst[m][k] = *(const PG8_LAS bf16x8*)(lds + PG8_SA(b, h) + aoff + m * 2048 + k * 1024); } while (0)
#define PG8_LDB(dst, b, h) do { _Pragma("unroll") for (int n = 0; n < 2; ++n) _Pragma("unroll") for (int k = 0; k < 2; ++k) dst[n][k] = *(const PG8_LAS bf16x8*)(lds + PG8_SB(b, h) + boff + n * 2048 + k * 1024); } while (0)
#define PG8_MMA(ai, bj, At, Bt) do { __builtin_amdgcn_s_setprio(1); _Pragma("unroll") for (int m = 0; m < 4; ++m) _Pragma("unroll") for (int n = 0; n < 2; ++n) _Pragma("unroll") for (int k = 0; k < 2; ++k) \
        acc[ai][bj][m][n] = __builtin_amdgcn_mfma_f32_16x16x32_bf16(Bt[n][k], At[m][k], acc[ai][bj][m][n], 0, 0, 0); __builtin_amdgcn_s_setprio(0); } while (0)
#define PG8_WAIT_V(n) asm volatile("s_waitcnt vmcnt(" #n ")" ::: "memory")
#define PG8_WAIT_L(n) asm volatile("s_waitcnt lgkmcnt(" #n ")" ::: "memory")
#define PG8_BAR __builtin_amdgcn_s_barrier()
#define PG8_SCHED __builtin_amdgcn_sched_barrier(0)
    Unit cur, nxt; int ui = 0;
    if (!S.next(0, cur)) return;
    f32x4 acc[2][2][4][2];
#pragma unroll
    for (int a = 0; a < 2; ++a)
#pragma unroll
        for (int b = 0; b < 2; ++b)
#pragma unroll
            for (int m = 0; m < 4; ++m)
#pragma unroll
                for (int n = 0; n < 2; ++n) acc[a][b][m][n] = (f32x4){0.f, 0.f, 0.f, 0.f};
    bf16x8 At[4][2], B0[2][2], B1[2][2];
    const char* cA = (const char*)g.A + (size_t)cur.pm * tstepA; const char* cB = (const char*)g.Bt + (size_t)cur.pn * tstepB;
    T.fill(cur, (PG8_LAS float*)(lds + STAGE_BYTES));
    if constexpr (SP2) {
        PG8_STAGE(PG8_SB(0, 0), cB, voffB); PG8_STAGE(PG8_SB(0, 1), cB + hstepB, voffB); PG8_STAGE(PG8_SA(0, 0), cA, voffA); PG8_STAGE(PG8_SA(0, 1), cA + hstepA, voffA);
        if (wr == 1) PG8_BAR;
        PG8_WAIT_V(2); PG8_BAR;
        PG8_STAGE(PG8_SB(1, 0), cB + kstep, voffB); PG8_STAGE(PG8_SA(1, 0), cA + kstep, voffA); PG8_STAGE(PG8_SB(1, 1), cB + hstepB + kstep, voffB);
        PG8_WAIT_V(6); PG8_BAR;
    } else {
        PG8_STAGE(PG8_SB(0, 0), cB, voffB); PG8_STAGE(PG8_SA(0, 0), cA, voffA); PG8_STAGE(PG8_SB(0, 1), cB + hstepB, voffB); PG8_STAGE(PG8_SA(0, 1), cA + hstepA, voffA);
        if (wr == 1) PG8_BAR;
        PG8_WAIT_V(4); PG8_BAR;
        PG8_STAGE(PG8_SB(1, 0), cB + kstep, voffB); PG8_STAGE(PG8_SA(1, 0), cA + kstep, voffA); PG8_STAGE(PG8_SB(1, 1), cB + hstepB + kstep, voffB);
        PG8_WAIT_V(6); PG8_BAR;
    }
    for (;;) {
        const bool has_next = S.next(ui + 1, nxt);
        const char* nA = has_next ? (const char*)g.A + (size_t)nxt.pm * tstepA : cA; const char* nB = has_next ? (const char*)g.Bt + (size_t)nxt.pn * tstepB : cB;
        for (int t = 0; t < nt; t += 2) {
            const bool last = (t == nt - 2);
            const char* a1 = cA + (size_t)(t + 1) * kstep;
            const char* a2 = last ? nA : cA + (size_t)(t + 2) * kstep; const char* b2 = last ? nB : cB + (size_t)(t + 2) * kstep;
            const char* a3 = a2 + kstep; const char* b3 = b2 + kstep;
            if (last && has_next) T.fill(nxt, (PG8_LAS float*)(lds + STAGE_BYTES + ((ui + 1) & 1) * 1024));
            if constexpr (SP2) {
            PG8_LDB(B0, 0, 0); PG8_LDB(B1, 0, 1); PG8_SCHED; PG8_LDA(At, 0, 0); PG8_STAGE(PG8_SA(1, 1), a1 + hstepA, voffA);
            PG8_WAIT_V(8); PG8_WAIT_L(0); PG8_BAR; PG8_MMA(0, 0, At, B0); PG8_MMA(0, 1, At, B1); PG8_BAR; PG8_SCHED;
            PG8_LDA(At, 0, 1); PG8_STAGE(PG8_SB(0, 0), b2, voffB); PG8_STAGE(PG8_SB(0, 1), b2 + hstepB, voffB); PG8_STAGE(PG8_SA(0, 0), a2, voffA);
            PG8_WAIT_V(8); PG8_WAIT_L(0); PG8_BAR; PG8_MMA(1, 0, At, B0); PG8_MMA(1, 1, At, B1); PG8_BAR; PG8_SCHED;
            PG8_LDB(B0, 1, 0); PG8_LDB(B1, 1, 1); PG8_SCHED; PG8_LDA(At, 1, 0); PG8_STAGE(PG8_SA(0, 1), a2 + hstepA, voffA);
            PG8_WAIT_V(8); PG8_WAIT_L(0); PG8_BAR; PG8_MMA(0, 0, At, B0); PG8_MMA(0, 1, At, B1); PG8_BAR; PG8_SCHED;
            PG8_LDA(At, 1, 1); PG8_STAGE(PG8_SB(1, 0), b3, voffB); PG8_STAGE(PG8_SB(1, 1), b3 + hstepB, voffB); PG8_STAGE(PG8_SA(1, 0), a3, voffA);
            PG8_WAIT_V(8); PG8_WAIT_L(0); PG8_BAR; PG8_MMA(1, 0, At, B0); PG8_MMA(1, 1, At, B1); PG8_BAR; PG8_SCHED;
            } else {
            PG8_LDB(B0, 0, 0); PG8_SCHED; PG8_LDA(At, 0, 0); PG8_STAGE(PG8_SA(1, 1), a1 + hstepA, voffA);
            PG8_WAIT_L(8); PG8_BAR; PG8_WAIT_L(0); PG8_MMA(0, 0, At, B0); PG8_BAR; PG8_SCHED;
            PG8_LDB(B1, 0, 1); PG8_STAGE(PG8_SB(0, 0), b2, voffB);
            PG8_BAR; PG8_WAIT_L(0); PG8_MMA(0, 1, At, B1); PG8_BAR;
            PG8_LDA(At, 0, 1); PG8_STAGE(PG8_SA(0, 0), a2, voffA);
            PG8_BAR; PG8_WAIT_L(0); PG8_MMA(1, 0, At, B0); PG8_BAR; PG8_SCHED;
            PG8_STAGE(PG8_SB(0, 1), b2 + hstepB, voffB);
            PG8_WAIT_V(6); PG8_BAR; PG8_MMA(1, 1, At, B1); PG8_BAR;
            PG8_LDB(B0, 1, 0); PG8_SCHED; PG8_LDA(At, 1, 0); PG8_STAGE(PG8_SA(0, 1), a2 + hstepA, voffA);
            PG8_WAIT_L(8); PG8_BAR; PG8_WAIT_L(0); PG8_MMA(0, 0, At, B0); PG8_BAR; PG8_SCHED;
            PG8_LDB(B1, 1, 1); PG8_STAGE(PG8_SB(1, 0), b3, voffB);
            PG8_BAR; PG8_WAIT_L(0); PG8_MMA(0, 1, At, B1); PG8_BAR;
            PG8_LDA(At, 1, 1); PG8_STAGE(PG8_SA(1, 0), a3, voffA);
            PG8_BAR; PG8_WAIT_L(0); PG8_MMA(1, 0, At, B0); PG8_BAR; PG8_SCHED;
            PG8_STAGE(PG8_SB(1, 1), b3 + hstepB, voffB);
            PG8_WAIT_V(6); PG8_BAR; PG8_MMA(1, 1, At, B1); PG8_BAR;
            }
        }
        if constexpr (ALIGN_EPI) { if (wr == 0) PG8_BAR; }
        E(acc, cur, wr, wc, fr, fq, (const PG8_LAS float*)(lds + STAGE_BYTES + (ui & 1) * 1024));
        if (!has_next) break;
#pragma unroll
        for (int a = 0; a < 2; ++a)
#pragma unroll
            for (int b = 0; b < 2; ++b)
#pragma unroll
                for (int m = 0; m < 4; ++m)
#pragma unroll
                    for (int n = 0; n < 2; ++n) acc[a][b][m][n] = (f32x4){0.f, 0.f, 0.f, 0.f};
        cur = nxt; cA = nA; cB = nB; ++ui;
        if constexpr (ALIGN_EPI) { if (wr == 1) PG8_BAR; }
    }
    PG8_WAIT_V(0);
    if constexpr (!ALIGN_EPI) { if (wr == 0) PG8_BAR; }
    PG8_BAR;
#undef PG8_SA
#undef PG8_SB
#undef PG8_STAGE
#undef PG8_LDA
#undef PG8_LDB
#undef PG8_MMA
#undef PG8_WAIT_V
#undef PG8_WAIT_L
#undef PG8_BAR
#undef PG8_SCHED
}
}

#define LAS __attribute__((address_space(3)))
typedef unsigned short bf16_t;
typedef short bf16x8 __attribute__((ext_vector_type(8)));
typedef float f32x4 __attribute__((ext_vector_type(4)));
typedef float f32x16 __attribute__((ext_vector_type(16)));
typedef unsigned u32x4 __attribute__((ext_vector_type(4)));
typedef unsigned u32x2 __attribute__((ext_vector_type(2)));

constexpr int BATCH = 2, SEQ = 8192, M = BATCH * SEQ, DM = 1024, NIN = 2560, FF = 4096;
constexpr float LOG2E = 1.4426950408889634f;
constexpr float SC_A = 0.125f * LOG2E, SC_B = 0.10206207261596575f * LOG2E, SC_C = 0.17677669529663687f * LOG2E;
constexpr float EPS = 1e-6f;

constexpr size_t MiB = 1u << 20;
constexpr size_t WS_CTL = 0;
constexpr size_t WS_COS64 = 1 * MiB, WS_SIN64 = 2 * MiB, WS_COS32 = 3 * MiB, WS_SIN32 = 3 * MiB + 512 * 1024;
constexpr size_t WS_SS1 = 4 * MiB, WS_SS2 = 5 * MiB, WS_LSE = 6 * MiB, WS_LAM = 7 * MiB + 512 * 1024;
constexpr size_t WS_W = 8 * MiB, W_LAYER = 24 * MiB;
constexpr size_t W_IN = 0, W_UQ = 5 * MiB, W_UKV = 5 * MiB + 768 * 1024, W_O = 6 * MiB, W_UP = 8 * MiB, W_DN = 16 * MiB;
constexpr size_t WS_XB = 56 * MiB, WS_OA = 56 * MiB, WS_MIX = 92 * MiB, WS_P = 124 * MiB, WS_QB = 204 * MiB, WS_KVB = 228 * MiB, WS_H = 124 * MiB, WS_END = 252 * MiB;
constexpr int LDS_BYTES = 147456;
constexpr int LDS_TAB = 131072, LDS_MISC = 131072 + 4096;

__device__ __forceinline__ float bf_lo(unsigned w) { return __uint_as_float(w << 16); }
__device__ __forceinline__ float bf_hi(unsigned w) { return __uint_as_float(w & 0xffff0000u); }
template <int PAT> __device__ __forceinline__ float swz(float v) { return __builtin_bit_cast(float, __builtin_amdgcn_ds_swizzle(__builtin_bit_cast(int, v), PAT)); }
__device__ __forceinline__ float xsum32(float v) { auto rr = __builtin_amdgcn_permlane32_swap(__float_as_uint(v), __float_as_uint(v), false, false); return __uint_as_float(rr[0]) + __uint_as_float(rr[1]); }
__device__ __forceinline__ u32x4 pack8(f32x4 a, f32x4 b) {
    u32x4 w; w.x = pg8::cvt_pk_bf16(a[0], a[1]); w.y = pg8::cvt_pk_bf16(a[2], a[3]); w.z = pg8::cvt_pk_bf16(b[0], b[1]); w.w = pg8::cvt_pk_bf16(b[2], b[3]); return w;
}
__device__ __forceinline__ void rope8(f32x4& a, f32x4& b, f32x4 cs, f32x4 sn) {
    float x, y;
    x = a[0]; y = a[1]; a[0] = x * cs[0] - y * sn[0]; a[1] = x * sn[0] + y * cs[0];
    x = a[2]; y = a[3]; a[2] = x * cs[1] - y * sn[1]; a[3] = x * sn[1] + y * cs[1];
    x = b[0]; y = b[1]; b[0] = x * cs[2] - y * sn[2]; b[1] = x * sn[2] + y * cs[2];
    x = b[2]; y = b[3]; b[2] = x * cs[3] - y * sn[3]; b[3] = x * sn[3] + y * cs[3];
}

struct TabNone { __device__ __forceinline__ void fill(const pg8::Unit&, LAS float*) const {} };
struct TabSS {
    const float* ss;
    __device__ __forceinline__ void fill(const pg8::Unit& u, LAS float* tab) const {
        int tid = threadIdx.x; asm volatile("" : "+v"(tid));
        if (tid < 256) {
            const f32x4* p = (const f32x4*)(ss + (size_t)(u.pm * 256 + tid) * 16);
            f32x4 s = p[0]; s = s + p[1]; s = s + p[2]; s = s + p[3];
            const float t = (s[0] + s[1]) + (s[2] + s[3]);
            tab[tid] = __builtin_amdgcn_rsqf(t * (1.f / 1024.f) + EPS);
        }
    }
};
template <int NCOLS> struct TabRows {
    const bf16_t* base; int pitch;
    __device__ __forceinline__ void fill(const pg8::Unit& u, LAS float* tab) const {
        int tid = threadIdx.x; asm volatile("" : "+v"(tid));
        const u32x4* p = (const u32x4*)(base + (size_t)(u.pm * 256 + (tid >> 1)) * pitch + (tid & 1) * (NCOLS / 2));
        float s = 0.f;
#pragma unroll 4
        for (int i = 0; i < NCOLS / 16; ++i) {
            const u32x4 v = p[i];
            s += bf_lo(v.x) * bf_lo(v.x) + bf_hi(v.x) * bf_hi(v.x) + bf_lo(v.y) * bf_lo(v.y) + bf_hi(v.y) * bf_hi(v.y)
               + bf_lo(v.z) * bf_lo(v.z) + bf_hi(v.z) * bf_hi(v.z) + bf_lo(v.w) * bf_lo(v.w) + bf_hi(v.w) * bf_hi(v.w);
        }
        s += swz<0x041f>(s);
        if (!(tid & 1)) tab[tid >> 1] = __builtin_amdgcn_rsqf(s * (1.f / NCOLS) + EPS);
    }
};

#define EPI_ROWS_BEGIN _Pragma("unroll") for (int ai = 0; ai < 2; ++ai) _Pragma("unroll") for (int m = 0; m < 4; ++m) { const int rl = ai * 128 + wr * 64 + m * 16 + fr; const int row = u.pm * 256 + rl;
#define EPI_ROWS_END }

struct EpiInProj {
    static constexpr bool PERM = true;
    bf16_t* P; const float* c64; const float* s64; const float* c32; const float* s32; int pn0;
    __device__ __forceinline__ void operator()(const f32x4 (&acc)[2][2][4][2], const pg8::Unit& u, int wr, int wc, int fr, int fq, const LAS float* tab) const {
#pragma unroll
        for (int bj = 0; bj < 2; ++bj) {
            const int cb = (u.pn + pn0) * 256 + bj * 128 + wc * 32, c0 = cb + 8 * fq;
            int typ = 0; float sc = 1.f;
            if (cb < 384) { typ = 1; sc = SC_A; } else if (cb < 768) typ = 1; else if (cb < 1664) typ = 0; else if (cb < 1696) typ = 2;
            else if (cb < 1792) typ = 0; else if (cb < 2048) { typ = 2; sc = SC_C; } else if (cb < 2304) typ = 2;
            EPI_ROWS_BEGIN
                const float rs = tab[rl] * sc;
                f32x4 v0 = acc[ai][bj][m][0] * rs, v1 = acc[ai][bj][m][1] * rs;
                if (typ == 1) { const int o = (row & (SEQ - 1)) * 32 + ((c0 & 63) >> 1); rope8(v0, v1, *(const f32x4*)(c64 + o), *(const f32x4*)(s64 + o)); }
                else if (typ == 2) { const int o = (row & (SEQ - 1)) * 16 + ((c0 & 31) >> 1); rope8(v0, v1, *(const f32x4*)(c32 + o), *(const f32x4*)(s32 + o)); }
                *(u32x4*)(P + (size_t)row * NIN + c0) = pack8(v0, v1);
            EPI_ROWS_END
        }
    }
};
struct EpiUq {
    static constexpr bool PERM = true;
    bf16_t* Q; const float* c32; const float* s32;
    __device__ __forceinline__ void operator()(const f32x4 (&acc)[2][2][4][2], const pg8::Unit& u, int wr, int wc, int fr, int fq, const LAS float* tab) const {
#pragma unroll
        for (int bj = 0; bj < 2; ++bj) {
            const int c0 = u.pn * 256 + bj * 128 + wc * 32 + 8 * fq;
            const bool ok = c0 < 576; const int h = c0 / 96, p = c0 - 96 * h; const bool rp = ok && p >= 64; const int i0 = rp ? ((p - 64) >> 1) : 0;
            EPI_ROWS_BEGIN
                const float rs = tab[rl] * SC_B;
                f32x4 v0 = acc[ai][bj][m][0] * rs, v1 = acc[ai][bj][m][1] * rs;
                const int o = (row & (SEQ - 1)) * 16 + i0;
                f32x4 cs = *(const f32x4*)(c32 + o), sn = *(const f32x4*)(s32 + o);
                if (!rp) { cs = (f32x4){1.f, 1.f, 1.f, 1.f}; sn = (f32x4){0.f, 0.f, 0.f, 0.f}; }
                rope8(v0, v1, cs, sn);
                if (ok) *(u32x4*)(Q + (size_t)row * 768 + c0) = pack8(v0, v1);
            EPI_ROWS_END
        }
    }
};
template <int ACT  > struct EpiScaled {
    static constexpr bool PERM = true;
    bf16_t* O; int ldc;
    __device__ __forceinline__ void operator()(const f32x4 (&acc)[2][2][4][2], const pg8::Unit& u, int wr, int wc, int fr, int fq, const LAS float* tab) const {
        EPI_ROWS_BEGIN
            const float rs = tab[rl];
#pragma unroll
            for (int bj = 0; bj < 2; ++bj) {
                const int c0 = u.pn * 256 + bj * 128 + wc * 32 + 8 * fq;
                f32x4 v0 = acc[ai][bj][m][0] * rs, v1 = acc[ai][bj][m][1] * rs;
                if (ACT == 1) {
#pragma unroll
                    for (int k = 0; k < 4; ++k) { const float a = fmaxf(v0[k], 0.f), b = fmaxf(v1[k], 0.f); v0[k] = a * a; v1[k] = b * b; }
                }
                *(u32x4*)(O + (size_t)row * ldc + c0) = pack8(v0, v1);
            }
        EPI_ROWS_END
    }
};
struct EpiResid {
    static constexpr bool PERM = true;
    const float* xin; float* xout; bf16_t* xb; float* ss;
    __device__ __forceinline__ void operator()(const f32x4 (&acc)[2][2][4][2], const pg8::Unit& u, int wr, int wc, int fr, int fq, const LAS float*) const {
        EPI_ROWS_BEGIN
            float sq = 0.f;
#pragma unroll
            for (int bj = 0; bj < 2; ++bj) {
                const size_t off = (size_t)row * DM + u.pn * 256 + bj * 128 + wc * 32 + 8 * fq;
                const f32x4 r0 = *(const f32x4*)(xin + off), r1 = *(const f32x4*)(xin + off + 4);
                const f32x4 v0 = r0 + acc[ai][bj][m][0], v1 = r1 + acc[ai][bj][m][1];
                *(f32x4*)(xout + off) = v0; *(f32x4*)(xout + off + 4) = v1;
                *(u32x4*)(xb + off) = pack8(v0, v1);
                sq += (v0[0] * v0[0] + v0[1] * v0[1]) + (v0[2] * v0[2] + v0[3] * v0[3]) + (v1[0] * v1[0] + v1[1] * v1[1]) + (v1[2] * v1[2] + v1[3] * v1[3]);
            }
            sq += swz<0x401f>(sq); sq = xsum32(sq);
            if (fq == 0) ss[(size_t)row * 16 + u.pn * 4 + wc] = sq;
        EPI_ROWS_END
    }
};

struct AttnBufs { const bf16_t* P; const bf16_t* QB; const bf16_t* KVB; bf16_t* OA; float* LSE; bf16_t* MIX; const float* subg; float lam; float oml; };
namespace att {
constexpr int KSTR = 1040, VOFF = 12544, VDH = 4160, BUFB = 20992, OST = 3 * BUFB, OSTW = 4608;
constexpr float NEG = -1e30f;
typedef short v4i16_t __attribute__((ext_vector_type(4)));
__device__ __forceinline__ int crow(int r, int hi) { return (r & 3) + 8 * (r >> 2) + 4 * hi; }
__device__ __forceinline__ v4i16_t vtr(const LAS unsigned char* p) { return __builtin_amdgcn_ds_read_tr16_b64_v4i16((LAS v4i16_t*)p); }
__device__ __forceinline__ float swapmax(float v) { auto rr = __builtin_amdgcn_permlane32_swap(__float_as_uint(v), __float_as_uint(v), false, false); return fmaxf(__uint_as_float(rr[0]), __uint_as_float(rr[1])); }
__device__ __forceinline__ float swapsum(float v) { auto rr = __builtin_amdgcn_permlane32_swap(__float_as_uint(v), __float_as_uint(v), false, false); return __uint_as_float(rr[0]) + __uint_as_float(rr[1]); }

__device__ __forceinline__ float max3f(float a, float b, float c) { float r; asm("v_max3_f32 %0, %1, %2, %3" : "=v"(r) : "v"(a), "v"(b), "v"(c)); return r; }
template <int TYPE, int DQ, int NMAP, int NQF, int NDS, bool BAND, int MPSEL>
__device__ __forceinline__ void att_qksm(const LAS unsigned char* Kb, const int kt, const int qw0, const int r32, const int hi, const int kofs,
                                         const bf16x8 (&qf)[NQF], f32x16 (&o)[NMAP][2], float (&mref)[NMAP], float (&lrun)[NMAP], f32x16 (&negm)[NMAP], const bool first, u32x4 (&pw)[NMAP][4]) {
    const int kmin = 64 * kt, kmax = kmin + 63;
    {
        bool needmask = kmax > qw0; if (BAND) needmask = needmask || (kmin + 128 < qw0 + 31);
#pragma unroll
        for (int mp = 0; mp < NMAP; ++mp) {
            if (MPSEL >= 0 && mp != MPSEL) continue;
            f32x16 s0, s1;
            if (NMAP == 1) { s0 = negm[mp]; s1 = negm[mp]; }
            else {
#pragma unroll
                for (int r = 0; r < 16; ++r) { s0[r] = -mref[mp]; s1[r] = s0[r]; }
            }
            constexpr int KH = NDS >= 4 ? NDS / 2 : NDS;
#pragma unroll
            for (int d1 = 0; d1 < NDS; d1 += KH) {
                bf16x8 kf0[KH], kf1[KH];
#pragma unroll
                for (int ds = 0; ds < KH; ++ds) {
                    kf0[ds] = *(const LAS bf16x8*)(Kb + kofs + (2 * (mp * NDS + d1 + ds)) * KSTR);
                    kf1[ds] = *(const LAS bf16x8*)(Kb + kofs + (2 * (mp * NDS + d1 + ds)) * KSTR + 512);
                }
                asm volatile("" ::: "memory");
#pragma unroll
                for (int ds = 0; ds < KH; ++ds) {
                    s0 = __builtin_amdgcn_mfma_f32_32x32x16_bf16(kf0[ds], qf[mp * NDS + d1 + ds], s0, 0, 0, 0);
                    s1 = __builtin_amdgcn_mfma_f32_32x32x16_bf16(kf1[ds], qf[mp * NDS + d1 + ds], s1, 0, 0, 0);
                }
            }
            if (needmask) {
                const int qpos = qw0 + r32;
#pragma unroll
                for (int r = 0; r < 16; ++r) {
                    const int kv0 = kmin + crow(r, hi), kv1 = kv0 + 32;
                    bool ok0 = kv0 <= qpos, ok1 = kv1 <= qpos;
                    if (BAND) { ok0 = ok0 && (kv0 + 128 >= qpos); ok1 = ok1 && (kv1 + 128 >= qpos); }
                    s0[r] = ok0 ? s0[r] : NEG; s1[r] = ok1 ? s1[r] : NEG;
                }
            }
            float ra = max3f(s0[0], s0[1], s1[0]), rb = max3f(s0[2], s0[3], s1[1]); ra = max3f(ra, s1[2], s1[3]);
#pragma unroll
            for (int r = 4; r < 16; r += 4) { ra = max3f(ra, s0[r], s0[r + 1]); rb = max3f(rb, s0[r + 2], s0[r + 3]); ra = max3f(ra, s1[r], s1[r + 1]); rb = max3f(rb, s1[r + 2], s1[r + 3]); }
            const float rm = swapmax(fmaxf(ra, rb));
            const float dl = first ? (rm > -1e29f ? rm : 0.f) : (rm > 8.f ? rm : 0.f);
            if (__any(dl != 0.f)) {
                mref[mp] += dl;
                const float f = __builtin_amdgcn_exp2f(-dl);
                lrun[mp] *= f;
#pragma unroll
                for (int r = 0; r < 16; ++r) { s0[r] -= dl; s1[r] -= dl; o[mp][0][r] *= f; o[mp][1][r] *= f; if (NMAP == 1) negm[mp][r] = -mref[mp]; }
            }
            float ps0 = 0.f, ps1 = 0.f;
#pragma unroll
            for (int r = 0; r < 16; ++r) { s0[r] = __builtin_amdgcn_exp2f(s0[r]); s1[r] = __builtin_amdgcn_exp2f(s1[r]); ps0 += s0[r]; ps1 += s1[r]; }
            lrun[mp] += ps0 + ps1;
#pragma unroll
            for (int k = 0; k < 2; ++k) {
                pw[mp][k]     = (u32x4){pg8::cvt_pk_bf16(s0[8 * k], s0[8 * k + 1]), pg8::cvt_pk_bf16(s0[8 * k + 2], s0[8 * k + 3]), pg8::cvt_pk_bf16(s0[8 * k + 4], s0[8 * k + 5]), pg8::cvt_pk_bf16(s0[8 * k + 6], s0[8 * k + 7])};
                pw[mp][2 + k] = (u32x4){pg8::cvt_pk_bf16(s1[8 * k], s1[8 * k + 1]), pg8::cvt_pk_bf16(s1[8 * k + 2], s1[8 * k + 3]), pg8::cvt_pk_bf16(s1[8 * k + 4], s1[8 * k + 5]), pg8::cvt_pk_bf16(s1[8 * k + 6], s1[8 * k + 7])};
            }
        }
    }
}
template <int NMAP, int MPSEL>
__device__ __forceinline__ void att_pv(const LAS unsigned char* Vb, f32x16 (&o)[NMAP][2], const u32x4 (&pw)[NMAP][4]) {
    constexpr int KB = 2;
#pragma unroll
    for (int kh = 0; kh < 4 / KB; ++kh) {
        v4i16_t vlo[KB][2], vhh[KB][2];
#pragma unroll
        for (int k2 = 0; k2 < KB; ++k2)
#pragma unroll
            for (int d0 = 0; d0 < 2; ++d0) { vlo[k2][d0] = vtr(Vb + d0 * VDH + (KB * kh + k2) * 1024); vhh[k2][d0] = vtr(Vb + d0 * VDH + (KB * kh + k2) * 1024 + 512); }
        asm volatile("" ::: "memory");
#pragma unroll
        for (int k2 = 0; k2 < KB; ++k2)
#pragma unroll
            for (int d0 = 0; d0 < 2; ++d0) {
                const bf16x8 vf = (bf16x8){vlo[k2][d0][0], vlo[k2][d0][1], vlo[k2][d0][2], vlo[k2][d0][3], vhh[k2][d0][0], vhh[k2][d0][1], vhh[k2][d0][2], vhh[k2][d0][3]};
#pragma unroll
                for (int mp = 0; mp < NMAP; ++mp) if (MPSEL < 0 || mp == MPSEL) o[mp][d0] = __builtin_amdgcn_mfma_f32_32x32x16_bf16(vf, __builtin_bit_cast(bf16x8, pw[mp][KB * kh + k2]), o[mp][d0], 0, 0, 0);
            }
    }
}

template <int TYPE>
__device__ __forceinline__ void attn_unit(LAS unsigned char* lds, const AttnBufs& A, int b, int h, int qb, int cfg, int res) {
    constexpr int DQ = TYPE == 0 ? 64 : (TYPE == 1 ? 96 : 32), NMAP = TYPE == 2 ? 2 : 1, NCH = NMAP * DQ / 8, NQF = NMAP * DQ / 16, NDS = DQ / 16;
    constexpr int NC1 = TYPE == 1 ? 8 : NCH, NKP = NCH * 64;
    constexpr bool BAND = TYPE == 0;
    int tid_ = threadIdx.x; asm volatile("" : "+v"(tid_));
    const int tid = tid_, lane = tid & 63, r32 = lane & 31, hi = lane >> 5;
    const int wid = __builtin_amdgcn_readfirstlane(tid >> 6);
    const int dil = (TYPE == 0) ? (cfg == 0 ? 1 : (cfg == 1 ? 4 : 16)) : 1;
    const long rowbase = (long)b * SEQ + res;
    const bf16_t *Qp, *K1p, *K2p, *Vp; int pQ, pK1, pK2, pV;
    if (TYPE == 0) { Qp = A.P + h * 64; pQ = NIN; K1p = A.P + 384 + h * 64; pK1 = NIN; K2p = K1p; pK2 = NIN; Vp = A.P + 768 + h * 64; pV = NIN; }
    else if (TYPE == 1) { Qp = A.QB + h * 96; pQ = 768; K1p = A.KVB + h * 128; pK1 = 768; K2p = A.P + 1664; pK2 = NIN; Vp = A.KVB + h * 128 + 64; pV = 768; }
    else { Qp = A.P + 1792 + h * 64; pQ = NIN; K1p = A.P + 2048 + h * 64; pK1 = NIN; K2p = K1p; pK2 = NIN; Vp = A.P + 2304 + h * 64; pV = NIN; }
    const int q0 = qb * 256, qw0 = q0 + wid * 32;
    const int kt_lo = BAND ? (qb > 0 ? 4 * qb - 2 : 0) : 0, kt_hi = 4 * qb + 4;
    bf16x8 qf[NQF];
    { const bf16_t* qrow = Qp + (rowbase + (long)dil * (qw0 + r32)) * pQ + hi * 8;
#pragma unroll
      for (int f = 0; f < NQF; ++f) qf[f] = *(const bf16x8*)(qrow + f * 16); }
    const bool k1ok = (NKP > 512) && (tid + 512 < NKP);
    const int p1 = k1ok ? tid + 512 : tid;
    const int krow0 = tid / NCH, kch0 = tid % NCH, krow1 = p1 / NCH, kch1 = p1 % NCH;
    const int vrow = tid >> 3, vch = tid & 7;
    const int kdst0 = kch0 * KSTR + krow0 * 16, kdst1 = kch1 * KSTR + krow1 * 16, vdst = VOFF + (vch >> 2) * VDH + vrow * 64 + (vch & 3) * 16;
    u32x4 kra0, kra1 = (u32x4){0u, 0u, 0u, 0u}, vra, krb0, krb1 = (u32x4){0u, 0u, 0u, 0u}, vrb;
    const char* kp0_; const char* kp1_; const char* vp_; long st0_, st1_, stv_;
    { const long g = rowbase + (long)dil * (64 * kt_lo + krow0);
      if (kch0 < NC1) { kp0_ = (const char*)(K1p + g * pK1 + kch0 * 8); st0_ = (long)dil * 64 * pK1 * 2; } else { kp0_ = (const char*)(K2p + g * pK2 + (kch0 - NC1) * 8); st0_ = (long)dil * 64 * pK2 * 2; } }
    { const long g = rowbase + (long)dil * (64 * kt_lo + krow1);
      if (kch1 < NC1) { kp1_ = (const char*)(K1p + g * pK1 + kch1 * 8); st1_ = (long)dil * 64 * pK1 * 2; } else { kp1_ = (const char*)(K2p + g * pK2 + (kch1 - NC1) * 8); st1_ = (long)dil * 64 * pK2 * 2; } }
    { const long g = rowbase + (long)dil * (64 * kt_lo + vrow); vp_ = (const char*)(Vp + g * pV + vch * 8); stv_ = (long)dil * 64 * pV * 2; }
#define ATT_LOADT(kt, kr0, kr1, vr) do { \
        kr0 = *(const u32x4*)kp0_; kp0_ += st0_; \
        if (NKP > 512) { kr1 = *(const u32x4*)kp1_; kp1_ += st1_; } \
        vr = *(const u32x4*)vp_; vp_ += stv_; } while (0)
#define ATT_STORET(bo, kr0, kr1, vr) do { *(LAS u32x4*)(lds + (bo) + kdst0) = kr0; if (k1ok) *(LAS u32x4*)(lds + (bo) + kdst1) = kr1; *(LAS u32x4*)(lds + (bo) + vdst) = vr; } while (0)
    f32x16 o[NMAP][2], negm[NMAP]; float mrun[NMAP], lrun[NMAP]; bool started = false;
#pragma unroll
    for (int mp = 0; mp < NMAP; ++mp) { mrun[mp] = 0.f; lrun[mp] = 0.f;
#pragma unroll
        for (int r = 0; r < 16; ++r) negm[mp][r] = 0.f;
#pragma unroll
        for (int d0 = 0; d0 < 2; ++d0)
#pragma unroll
            for (int r = 0; r < 16; ++r) o[mp][d0][r] = 0.f; }
    const int kofs = hi * KSTR + r32 * 16;
    const int vofs = VOFF + ((lane >> 4) & 1) * 32 + (lane & 3) * 8 + (4 * hi + ((lane & 15) >> 2)) * 64;
    const bool lag = (NMAP == 1) && wid >= 4;
    int bp = 0, bc = 0, bn = BUFB;
#define ATT_ROT() do { bp = bc; bc = bn; bn = (bn == 2 * BUFB) ? 0 : bn + BUFB; } while (0)
#define ATT_LOOP(STEP) \
    for (int kt = kt_lo; kt < kt_hi; kt += 2) {     \
        const bool more = kt + 2 < kt_hi; \
        const int ktn = more ? kt + 2 : kt;            \
        ATT_LOADT(ktn, kra0, kra1, vra); \
        STEP(kt); \
        ATT_STORET(bn, krb0, krb1, vrb); \
        __syncthreads(); \
        ATT_ROT(); \
        ATT_LOADT(ktn + 1, krb0, krb1, vrb); \
        STEP(kt + 1); \
        if (more) ATT_STORET(bn, kra0, kra1, vra); \
        __syncthreads(); \
        ATT_ROT(); \
    }
#define ATT_ACTIVE(kt_) ((64 * (kt_) <= qw0 + 31) && (!BAND || (64 * (kt_) + 63 + 128 >= qw0)))
#define ATT_QKSM(kt_, MP, pw_) att_qksm<TYPE, DQ, NMAP, NQF, NDS, BAND, MP>(lds + bc, (kt_), qw0, r32, hi, kofs, qf, o, mrun, lrun, negm, first_, pw_)
#define ATT_STEP_N(kt_) do { if (ATT_ACTIVE(kt_)) { const bool first_ = !started; started = true; u32x4 pw[NMAP][4]; \
            if (NMAP == 1) { ATT_QKSM(kt_, -1, pw); att_pv<NMAP, -1>(lds + bc + vofs, o, pw); } \
            else { ATT_QKSM(kt_, 0, pw); att_pv<NMAP, 0>(lds + bc + vofs, o, pw); ATT_QKSM(kt_, NMAP - 1, pw); att_pv<NMAP, NMAP - 1>(lds + bc + vofs, o, pw); } } } while (0)
#define ATT_STEP_L(kt_) do { if (pend) att_pv<NMAP, -1>(lds + bp + vofs, o, pwl); pend = false; \
        if (ATT_ACTIVE(kt_)) { const bool first_ = !started; started = true; ATT_QKSM(kt_, -1, pwl); pend = true; } } while (0)
    ATT_LOADT(kt_lo, kra0, kra1, vra); ATT_LOADT(kt_lo + 1, krb0, krb1, vrb); ATT_STORET(0, kra0, kra1, vra);
    __syncthreads();
    if (!lag) {
        ATT_LOOP(ATT_STEP_N)
    } else {
        u32x4 pwl[NMAP][4]; bool pend = false;
        ATT_LOOP(ATT_STEP_L)
        if (pend) att_pv<NMAP, -1>(lds + bp + vofs, o, pwl);
    }
    __syncthreads();
#undef ATT_STEP_N
#undef ATT_ACTIVE
#undef ATT_QKSM
#undef ATT_STEP_L
#undef ATT_LOOP
#undef ATT_ROT
#undef ATT_LOADT
#undef ATT_STORET
    float linv[NMAP], ltot[NMAP];
#pragma unroll
    for (int mp = 0; mp < NMAP; ++mp) { ltot[mp] = swapsum(lrun[mp]); linv[mp] = 1.f / ltot[mp]; }
    f32x16 val[2];
    if (TYPE == 2) {
        float sq = 0.f;
#pragma unroll
        for (int d0 = 0; d0 < 2; ++d0)
#pragma unroll
            for (int r = 0; r < 16; ++r) { const float v = o[0][d0][r] * linv[0] - A.lam * (o[NMAP - 1][d0][r] * linv[NMAP - 1]); val[d0][r] = v; sq += v * v; }
        sq = swapsum(sq);
        const float rs = __builtin_amdgcn_rsqf(sq * (1.f / 64.f) + 1e-5f) * A.oml;
#pragma unroll
        for (int d0 = 0; d0 < 2; ++d0)
#pragma unroll
            for (int g4 = 0; g4 < 4; ++g4) { const f32x4 gg = *(const f32x4*)(A.subg + 32 * d0 + 8 * g4 + 4 * hi);
#pragma unroll
                for (int k = 0; k < 4; ++k) val[d0][4 * g4 + k] *= rs * gg[k]; }
    } else {
#pragma unroll
        for (int d0 = 0; d0 < 2; ++d0)
#pragma unroll
            for (int r = 0; r < 16; ++r) val[d0][r] = o[0][d0][r] * linv[0];
    }
    LAS unsigned char* stg = lds + OST + wid * OSTW;
#pragma unroll
    for (int d0 = 0; d0 < 2; ++d0)
#pragma unroll
        for (int g4 = 0; g4 < 4; ++g4) {
            u32x2 w; w.x = pg8::cvt_pk_bf16(val[d0][4 * g4], val[d0][4 * g4 + 1]); w.y = pg8::cvt_pk_bf16(val[d0][4 * g4 + 2], val[d0][4 * g4 + 3]);
            *(LAS u32x2*)(stg + r32 * 144 + (32 * d0 + 8 * g4 + 4 * hi) * 2) = w;
        }
    bf16_t* Out; int pO;
    if (TYPE == 0) { Out = A.OA + (size_t)cfg * M * 384 + h * 64; pO = 384; }
    else if (TYPE == 1) { Out = A.MIX + 384 + h * 64; pO = DM; }
    else { Out = A.MIX + 768 + h * 64; pO = DM; }
#pragma unroll
    for (int i = 0; i < 4; ++i) {
        const int rr = 8 * i + (lane >> 3), ch = lane & 7;
        const u32x4 v = *(const LAS u32x4*)(stg + rr * 144 + ch * 16);
        *(u32x4*)(Out + (rowbase + (long)dil * (qw0 + rr)) * pO + ch * 8) = v;
    }
    if (TYPE == 0) { if (hi == 0) A.LSE[((size_t)cfg * M + rowbase + (long)dil * (qw0 + r32)) * 8 + h] = mrun[0] + __log2f(ltot[0]); }
}
}

constexpr int ATT_UNITS = 640 + 1152;
__device__ __forceinline__ void attn_phase(LAS unsigned char* lds, const AttnBufs& A, unsigned* ctr) {
    volatile LAS int* sh = (volatile LAS int*)(lds + LDS_MISC);
    for (;;) {
        if (threadIdx.x == 0) *sh = (int)atomicAdd(ctr, 1u);
        __syncthreads();
        const int idx = __builtin_amdgcn_readfirstlane(*sh);
        __syncthreads();
        if (idx >= ATT_UNITS) break;
        if (idx < 640) {
            const int qb = 31 - idx / 20, j = idx % 20;
            if (j < 12) att::attn_unit<1>(lds, A, j / 6, j % 6, qb, 0, 0);
            else att::attn_unit<2>(lds, A, (j - 12) / 4, (j - 12) % 4, qb, 0, 0);
        } else {
            const int a = idx - 640, cfg = a / 384, rem = a % 384, b = rem / 192, h = (rem / 32) % 6, tile = rem % 32;
            const int dl = cfg == 0 ? 1 : (cfg == 1 ? 4 : 16);
            att::attn_unit<0>(lds, A, b, h, tile / dl, cfg, tile % dl);
        }
    }
}

__device__ __forceinline__ float wave_sum(float v) {
    v += swz<0x041f>(v); v += swz<0x081f>(v); v += swz<0x101f>(v); v += swz<0x201f>(v); v += swz<0x401f>(v);
    return xsum32(v);
}
__device__ __forceinline__ int src_col(int kind, int n) {
    if (kind == 0) {
        if (n < 768) { const int blk = n >> 6, p = n & 63; return (blk << 6) + ((p & 1) ? 32 + (p >> 1) : (p >> 1)); }
        if (n < 1664) return n;
        if (n < 1696) { const int p = n - 1664; return 1664 + ((p & 1) ? 16 + (p >> 1) : (p >> 1)); }
        if (n < 1792) return -1;
        if (n < 2304) { const int q = n - 1792, blk = q >> 5, p = q & 31; return 1696 + (blk << 5) + ((p & 1) ? 16 + (p >> 1) : (p >> 1)); }
        return n - 96;
    }
    if (kind == 1) { if (n >= 576) return -1; const int h = n / 96, p = n % 96; if (p < 64) return n; const int q = p - 64; return h * 96 + 64 + ((q & 1) ? 16 + (q >> 1) : (q >> 1)); }
    return n;
}
struct TItem { const float* W; const float* g; bf16_t* WT; int K, Nsrc, Ndst, kind, item; };
__device__ __forceinline__ void titem_load(const TItem& t, int lane, float (&v)[32]) {
    const int nblk = t.Ndst / 32, kb = t.item / nblk, nb = t.item % nblk, k0 = 64 * kb, n0 = 32 * nb;
    const int sc = src_col(t.kind, n0 + (lane & 31));
#pragma unroll
    for (int i = 0; i < 32; ++i) { const int kk = 2 * i + (lane >> 5);
        float x = 0.f; if (sc >= 0) { x = t.W[(size_t)(k0 + kk) * t.Nsrc + sc]; if (t.g) x *= t.g[k0 + kk]; }
        v[i] = x; }
}
__device__ __forceinline__ void titem_finish(const TItem& t, int lane, const float (&v)[32], LAS float* scr) {
    const int nblk = t.Ndst / 32, kb = t.item / nblk, nb = t.item % nblk, k0 = 64 * kb, n0 = 32 * nb;
#pragma unroll
    for (int i = 0; i < 32; ++i) scr[(2 * i + (lane >> 5)) * 33 + (lane & 31)] = v[i];
    asm volatile("s_waitcnt lgkmcnt(0)" ::: "memory");
    const int c = lane & 7;
#pragma unroll
    for (int j = 0; j < 4; ++j) { const int n = (lane >> 3) + 8 * j; const LAS float* p = scr + (8 * c) * 33 + n;
        u32x4 o; o.x = pg8::cvt_pk_bf16(p[0 * 33], p[1 * 33]); o.y = pg8::cvt_pk_bf16(p[2 * 33], p[3 * 33]); o.z = pg8::cvt_pk_bf16(p[4 * 33], p[5 * 33]); o.w = pg8::cvt_pk_bf16(p[6 * 33], p[7 * 33]);
        *(u32x4*)(t.WT + (size_t)(n0 + n) * t.K + k0 + 8 * c) = o; }
    asm volatile("s_waitcnt lgkmcnt(0)" ::: "memory");
}

#define XB_TMO      128
#define XB_XCNT(j)  (256  + 64 * (j))
#define XB_XSUB(j)  (1280 + 64 * (j))
#define XB_XGEN(j)  (2304 + 64 * (j))
#define XB_TOP      3328
#define XB_TOPGEN   3392
#define XCD_BAR_WORDS 3456
#define XB_SPIN_CAP (1u << 18)

__device__ __forceinline__ unsigned xb_ld(unsigned* p)              { return __hip_atomic_load(p, __ATOMIC_RELAXED, __HIP_MEMORY_SCOPE_AGENT); }
__device__ __forceinline__ unsigned xb_add(unsigned* p, unsigned v) { return __hip_atomic_fetch_add(p, v, __ATOMIC_RELAXED, __HIP_MEMORY_SCOPE_AGENT); }
__device__ __forceinline__ unsigned xb_xcc_id() { return (unsigned)__builtin_amdgcn_s_getreg((3 << 11) | 20) & 0xFu; }
#define XB_SPIN(cond, bar) do { unsigned _sp = 0; while (cond) { __builtin_amdgcn_s_sleep(1); \
    if ((++_sp & 255u) == 0u) { if (xb_ld(&(bar)[XB_TMO])) break; if (_sp > XB_SPIN_CAP) { atomicAdd(&(bar)[XB_TMO], 1u); break; } } } } while (0)

struct XcdBarrier {
    unsigned* bar; unsigned x;
    volatile LAS unsigned* st;
};
__device__ __forceinline__ XcdBarrier xcd_barrier_post(unsigned* bar, volatile LAS unsigned* st) {
    XcdBarrier b; b.bar = bar; b.x = xb_xcc_id(); b.st = st;
    if (threadIdx.x == 0) (void)xb_add(&bar[XB_XCNT(b.x)], 1u);
    return b;
}
__device__ __forceinline__ void xcd_barrier_complete(unsigned* bar, unsigned x, unsigned& nloc, unsigned& nx) {
    const unsigned G = gridDim.x * gridDim.y * gridDim.z;
    unsigned sum, cnt, mine, sp = 0u;
    for (;;) {
        sum = 0u; cnt = 0u; mine = 0u;
#pragma unroll
        for (unsigned j = 0; j < 16; ++j) { const unsigned c = xb_ld(&bar[XB_XCNT(j)]); sum += c; cnt += (c > 0u) ? 1u : 0u; mine = (j == x) ? c : mine; }
        if (sum == G) break;
        __builtin_amdgcn_s_sleep(1);
        if ((++sp & 255u) == 0u) { if (xb_ld(&bar[XB_TMO])) break; if (sp > XB_SPIN_CAP) { atomicAdd(&bar[XB_TMO], 1u); break; } }
    }
    nloc = mine > 0u ? mine : 1u; nx = cnt > 0u ? cnt : 1u;
}

__device__ __forceinline__ void xcd_barrier(const XcdBarrier& b) {
    asm volatile("s_waitcnt vmcnt(0)" ::: "memory");
    __syncthreads();
    if (threadIdx.x == 0) {
        unsigned* bar = b.bar;
        __builtin_amdgcn_s_waitcnt(0);
        unsigned nloc = b.st[0], nx = b.st[1];
        if (nloc == 0u) { xcd_barrier_complete(bar, b.x, nloc, nx); b.st[0] = nloc; b.st[1] = nx; }
        const unsigned old = xb_add(&bar[XB_XSUB(b.x)], 1u);
        const unsigned gen = old / nloc;
        if (old + 1u == (gen + 1u) * nloc) {
            __builtin_amdgcn_fence(__ATOMIC_RELEASE, "agent");
            asm volatile("s_waitcnt vmcnt(0)" ::: "memory");
            const unsigned og = xb_add(&bar[XB_TOP], 1u);
            const unsigned tg = og / nx;
            if (og + 1u == (tg + 1u) * nx) xb_add(&bar[XB_TOPGEN], 1u);
            else XB_SPIN(xb_ld(&bar[XB_TOPGEN]) == tg, bar);
            __builtin_amdgcn_fence(__ATOMIC_ACQUIRE, "agent");
            xb_add(&bar[XB_XGEN(b.x)], 1u);
            asm volatile("s_waitcnt vmcnt(0)" ::: "memory");
        } else {
            XB_SPIN(xb_ld(&bar[XB_XGEN(b.x)]) == gen, bar);
            __builtin_amdgcn_fence(__ATOMIC_ACQUIRE, "agent");
            asm volatile("s_waitcnt vmcnt(0)" ::: "memory");
        }
    }
    __syncthreads();
}

struct Params { const float* in[14]; float* out; unsigned char* ws; float inv64[32]; float inv32[16]; };

__global__ void __launch_bounds__(512, 2) hybrid_fwd(Params p) {
    extern __shared__ __attribute__((aligned(16))) unsigned char lds_raw[];
    LAS unsigned char* lds = (LAS unsigned char*)lds_raw;
    cg::grid_group grid = cg::this_grid();
    if (threadIdx.x < 4) ((volatile LAS unsigned*)(lds + LDS_MISC + 64))[threadIdx.x] = 0u;
    __syncthreads();
    { XcdBarrier b0 = xcd_barrier_post((unsigned*)(p.ws + WS_CTL) + 1024, (volatile LAS unsigned*)(lds + LDS_MISC + 64)); (void)b0; }
#define GRID_BAR() do { XcdBarrier b_; b_.bar = (unsigned*)(p.ws + WS_CTL) + 1024; b_.x = xb_xcc_id(); b_.st = (volatile LAS unsigned*)(lds + LDS_MISC + 64); xcd_barrier(b_); } while (0)
#define WSP(name) size_t name##_off = 0; asm volatile("" : "+s"(name##_off)); unsigned char* name = p.ws + name##_off; int bx = blockIdx.x; asm volatile("" : "+s"(bx)); int G = gridDim.x; asm volatile("" : "+s"(G))
#define PTR(T, v, off) T* v = (T*)(ws + (off))
    grid.sync();
    {
        WSP(ws); const float* x = p.in[0];
        PTR(float, cos64, WS_COS64); PTR(float, sin64, WS_SIN64); PTR(float, cos32, WS_COS32); PTR(float, sin32, WS_SIN32); PTR(float, SS1, WS_SS1); PTR(float, LAM, WS_LAM); PTR(bf16_t, XB, WS_XB);
        int tid = threadIdx.x; asm volatile("" : "+v"(tid)); const int lane = tid & 63, wave = __builtin_amdgcn_readfirstlane(tid >> 6);
        LAS float* scr = (LAS float*)(lds + wave * 16384);
        const int gw = bx * 8 + wave, NGW = G * 8;
        constexpr int I_IN = 16 * 80, I_UQ = 6 * 24, I_UKV = 2 * 24, I_O = 16 * 32, I_UP = 16 * 128, I_DN = 64 * 32, I_L = I_IN + I_UQ + I_UKV + I_O + I_UP + I_DN;
#define TI_DECODE(t, it_) do { const int L_ = (it_) / I_L; int r_ = (it_) % I_L; unsigned char* wl_ = ws + WS_W + (size_t)L_ * W_LAYER; \
            if (r_ < I_IN) { t = TItem{p.in[2] + (size_t)L_ * 1024 * 2464, p.in[1] + L_ * 1024, (bf16_t*)(wl_ + W_IN), 1024, 2464, NIN, 0, r_}; break; } r_ -= I_IN; \
            if (r_ < I_UQ) { t = TItem{p.in[4] + (size_t)L_ * 384 * 576, p.in[3] + L_ * 384, (bf16_t*)(wl_ + W_UQ), 384, 576, 768, 1, r_}; break; } r_ -= I_UQ; \
            if (r_ < I_UKV) { t = TItem{p.in[6] + (size_t)L_ * 128 * 768, p.in[5] + L_ * 128, (bf16_t*)(wl_ + W_UKV), 128, 768, 768, 2, r_}; break; } r_ -= I_UKV; \
            if (r_ < I_O) { t = TItem{p.in[9] + (size_t)L_ * 1024 * 1024, nullptr, (bf16_t*)(wl_ + W_O), 1024, 1024, 1024, 2, r_}; break; } r_ -= I_O; \
            if (r_ < I_UP) { t = TItem{p.in[11] + (size_t)L_ * 1024 * 4096, p.in[10] + L_ * 1024, (bf16_t*)(wl_ + W_UP), 1024, 4096, 4096, 2, r_}; break; } r_ -= I_UP; \
            t = TItem{p.in[12] + (size_t)L_ * 4096 * 1024, nullptr, (bf16_t*)(wl_ + W_DN), 4096, 1024, 1024, 2, r_}; } while (0)
        for (int it = gw; it < 2 * I_L; it += 2 * NGW) {
            const bool two = it + NGW < 2 * I_L;
            TItem ta, tb; TI_DECODE(ta, it); TI_DECODE(tb, two ? it + NGW : it);
            float va[32], vb[32];
            titem_load(ta, lane, va); titem_load(tb, lane, vb);
            titem_finish(ta, lane, va, scr);
            if (two) titem_finish(tb, lane, vb, scr);
        }
#undef TI_DECODE
        for (int mrow = gw; mrow < M; mrow += 2 * NGW) {
            const int mrow2 = mrow + NGW;
            const f32x4* xr = (const f32x4*)(x + (size_t)mrow * DM) + lane; const f32x4* xr2 = (const f32x4*)(x + (size_t)mrow2 * DM) + lane;
            f32x4 v[4], w2[4];
#pragma unroll
            for (int j = 0; j < 4; ++j) { v[j] = xr[64 * j]; w2[j] = xr2[64 * j]; }
            float s = 0.f, s2 = 0.f;
#pragma unroll
            for (int j = 0; j < 4; ++j) {
                s += (v[j][0] * v[j][0] + v[j][1] * v[j][1]) + (v[j][2] * v[j][2] + v[j][3] * v[j][3]);
                s2 += (w2[j][0] * w2[j][0] + w2[j][1] * w2[j][1]) + (w2[j][2] * w2[j][2] + w2[j][3] * w2[j][3]);
                u32x2 w; w.x = pg8::cvt_pk_bf16(v[j][0], v[j][1]); w.y = pg8::cvt_pk_bf16(v[j][2], v[j][3]); *((u32x2*)(XB + (size_t)mrow * DM) + lane + 64 * j) = w;
                u32x2 u; u.x = pg8::cvt_pk_bf16(w2[j][0], w2[j][1]); u.y = pg8::cvt_pk_bf16(w2[j][2], w2[j][3]); *((u32x2*)(XB + (size_t)mrow2 * DM) + lane + 64 * j) = u; }
            s = wave_sum(s); s2 = wave_sum(s2);
            if (lane < 16) { SS1[(size_t)mrow * 16 + lane] = lane == 0 ? s : 0.f; SS1[(size_t)mrow2 * 16 + lane] = lane == 0 ? s2 : 0.f; }
        }
        const int gt = bx * 512 + tid, NGT = G * 512;
        for (int i = gt; i < SEQ * 48; i += NGT) {
            const int t = i / 48, j = i % 48;
            const float inv = j < 32 ? p.inv64[j] : p.inv32[j - 32];
            const float ang = (float)t * inv;
            double f = (double)ang * 0.15915494309189535; f -= __builtin_rint(f);
            const float ff = (float)f, c = __builtin_amdgcn_cosf(ff), s = __builtin_amdgcn_sinf(ff);
            if (j < 32) { cos64[t * 32 + j] = c; sin64[t * 32 + j] = s; } else { cos32[t * 16 + j - 32] = c; sin32[t * 16 + j - 32] = s; }
        }
        if (bx == 0 && tid < 2) {
            const float* lp = p.in[7] + tid * 128; float s1 = 0.f, s2 = 0.f;
            for (int i = 0; i < 32; ++i) { s1 += lp[i] * lp[32 + i]; s2 += lp[64 + i] * lp[96 + i]; }
            const float li = 0.8f - 0.6f * expf(-0.3f * (float)tid);
            LAM[tid * 2] = expf(s1) - expf(s2) + li; LAM[tid * 2 + 1] = 1.f - li;
        }
    }
    GRID_BAR();

    for (int L = 0; L < 2; ++L) {
        {
            WSP(ws); unsigned char* wl = ws + WS_W + (size_t)L * W_LAYER;
            PTR(float, cos64, WS_COS64); PTR(float, sin64, WS_SIN64); PTR(float, cos32, WS_COS32); PTR(float, sin32, WS_SIN32); PTR(float, SS1, WS_SS1); PTR(bf16_t, XB, WS_XB); PTR(bf16_t, Pb, WS_P);
            pg8::Gemm g{XB, (const bf16_t*)(wl + W_IN), M, 2048, 1024, 1024}; pg8::StaticOrder S; S.init(M, 2048, G, bx);
            EpiInProj E{Pb, cos64, sin64, cos32, sin32, 0}; TabSS T{SS1};
            pg8::gemm_phase<EpiInProj, pg8::StaticOrder, TabSS, true, true>(lds, g, S, E, T);
        }
        GRID_BAR();
        {
            const int Gh = (int)gridDim.x / 2;
            {
                WSP(ws); unsigned char* wl = ws + WS_W + (size_t)L * W_LAYER;
                PTR(float, cos64, WS_COS64); PTR(float, sin64, WS_SIN64); PTR(float, cos32, WS_COS32); PTR(float, sin32, WS_SIN32); PTR(float, SS1, WS_SS1); PTR(bf16_t, XB, WS_XB); PTR(bf16_t, Pb, WS_P);
                pg8::Gemm g{XB, (const bf16_t*)(wl + W_IN) + (size_t)2048 * 1024, M, 512, 1024, 1024}; pg8::StaticOrder S; S.init(M, 512, Gh, bx < Gh ? bx : (1 << 28));
                EpiInProj E{Pb, cos64, sin64, cos32, sin32, 8}; TabSS T{SS1};
                pg8::gemm_phase<EpiInProj, pg8::StaticOrder, TabSS, true, true>(lds, g, S, E, T);
            }
            {
                WSP(ws); unsigned char* wl = ws + WS_W + (size_t)L * W_LAYER; PTR(float, cos32, WS_COS32); PTR(float, sin32, WS_SIN32); PTR(bf16_t, Pb, WS_P); PTR(bf16_t, QB, WS_QB);
                pg8::Gemm g{Pb + 1152, (const bf16_t*)(wl + W_UQ), M, 768, 384, NIN}; pg8::StaticOrder S; S.init(M, 768, Gh, bx >= Gh ? bx - Gh : (1 << 28));
                EpiUq E{QB, cos32, sin32}; TabRows<384> T{Pb + 1152, NIN};
                pg8::gemm_phase<EpiUq, pg8::StaticOrder, TabRows<384>, true, true>(lds, g, S, E, T);
            }
            {
                WSP(ws); unsigned char* wl = ws + WS_W + (size_t)L * W_LAYER; PTR(bf16_t, Pb, WS_P); PTR(bf16_t, KVB, WS_KVB);
                pg8::Gemm g{Pb + 1536, (const bf16_t*)(wl + W_UKV), M, 768, 128, NIN}; pg8::StaticOrder S; S.init(M, 768, Gh, bx >= Gh ? (bx - Gh + Gh / 2) % Gh : (1 << 28));
                EpiScaled<0> E{KVB, 768}; TabRows<128> T{Pb + 1536, NIN};
                pg8::gemm_phase<EpiScaled<0>, pg8::StaticOrder, TabRows<128>, true, true>(lds, g, S, E, T);
            }
        }
        GRID_BAR();
        {
            WSP(ws); PTR(bf16_t, Pb, WS_P); PTR(bf16_t, QB, WS_QB); PTR(bf16_t, KVB, WS_KVB); PTR(bf16_t, OA, WS_OA); PTR(float, LSE, WS_LSE); PTR(bf16_t, MIX, WS_MIX); PTR(float, LAM, WS_LAM); PTR(unsigned, ctl, WS_CTL);
            AttnBufs A{Pb, QB, KVB, OA, LSE, MIX, p.in[8] + L * 64, LAM[L * 2], LAM[L * 2 + 1]};
            attn_phase(lds, A, ctl + 64 * L);
        }
        GRID_BAR();
        {
            WSP(ws); PTR(bf16_t, OA, WS_OA); PTR(float, LSE, WS_LSE); PTR(bf16_t, MIX, WS_MIX);
            int gt = bx * 512 + threadIdx.x; asm volatile("" : "+v"(gt)); const int NGT = G * 512;
            for (int it = gt; it < M * 48; it += NGT) {
                const int row = it / 48, j = it % 48, h = j >> 3, ch = j & 7;
                const float l0 = LSE[(size_t)row * 8 + h], l1 = LSE[((size_t)M + row) * 8 + h], l2 = LSE[((size_t)2 * M + row) * 8 + h];
                const float mx = fmaxf(l0, fmaxf(l1, l2));
                float w0 = __builtin_amdgcn_exp2f(l0 - mx), w1 = __builtin_amdgcn_exp2f(l1 - mx), w2 = __builtin_amdgcn_exp2f(l2 - mx);
                const float inv = 1.f / (w0 + w1 + w2); w0 *= inv; w1 *= inv; w2 *= inv;
                const size_t o = (size_t)row * 384 + h * 64 + ch * 8;
                const u32x4 a = *(const u32x4*)(OA + o), b = *(const u32x4*)(OA + (size_t)M * 384 + o), c = *(const u32x4*)(OA + (size_t)2 * M * 384 + o);
                f32x4 v0, v1;
                v0[0] = w0 * bf_lo(a.x) + w1 * bf_lo(b.x) + w2 * bf_lo(c.x); v0[1] = w0 * bf_hi(a.x) + w1 * bf_hi(b.x) + w2 * bf_hi(c.x);
                v0[2] = w0 * bf_lo(a.y) + w1 * bf_lo(b.y) + w2 * bf_lo(c.y); v0[3] = w0 * bf_hi(a.y) + w1 * bf_hi(b.y) + w2 * bf_hi(c.y);
                v1[0] = w0 * bf_lo(a.z) + w1 * bf_lo(b.z) + w2 * bf_lo(c.z); v1[1] = w0 * bf_hi(a.z) + w1 * bf_hi(b.z) + w2 * bf_hi(c.z);
                v1[2] = w0 * bf_lo(a.w) + w1 * bf_lo(b.w) + w2 * bf_lo(c.w); v1[3] = w0 * bf_hi(a.w) + w1 * bf_hi(b.w) + w2 * bf_hi(c.w);
                *(u32x4*)(MIX + (size_t)row * DM + h * 64 + ch * 8) = pack8(v0, v1);
            }
        }
        GRID_BAR();
        {
            WSP(ws); unsigned char* wl = ws + WS_W + (size_t)L * W_LAYER; PTR(bf16_t, MIX, WS_MIX); PTR(bf16_t, XB, WS_XB); PTR(float, SS2, WS_SS2); const float* x = p.in[0]; float* out = p.out;
            pg8::Gemm g{MIX, (const bf16_t*)(wl + W_O), M, 1024, 1024, 1024}; pg8::StaticOrder S; S.init(M, 1024, G, bx);
            EpiResid E{L == 0 ? x : (const float*)out, out, XB, SS2}; TabNone T;
            pg8::gemm_phase<EpiResid, pg8::StaticOrder, TabNone, true, true>(lds, g, S, E, T);
        }
        GRID_BAR();
        {
            WSP(ws); unsigned char* wl = ws + WS_W + (size_t)L * W_LAYER; PTR(bf16_t, XB, WS_XB); PTR(bf16_t, HB, WS_H); PTR(float, SS2, WS_SS2);
            pg8::Gemm g{XB, (const bf16_t*)(wl + W_UP), M, FF, 1024, 1024}; pg8::StaticOrder S; S.init(M, FF, G, bx);
            EpiScaled<1> E{HB, FF}; TabSS T{SS2};
            pg8::gemm_phase<EpiScaled<1>, pg8::StaticOrder, TabSS, true, true>(lds, g, S, E, T);
        }
        GRID_BAR();
        {
            WSP(ws); unsigned char* wl = ws + WS_W + (size_t)L * W_LAYER; PTR(bf16_t, XB, WS_XB); PTR(bf16_t, HB, WS_H); PTR(float, SS1, WS_SS1); float* out = p.out;
            pg8::Gemm g{HB, (const bf16_t*)(wl + W_DN), M, 1024, FF, FF}; pg8::StaticOrder S; S.init(M, 1024, G, bx);
            EpiResid E{out, out, XB, SS1}; TabNone T;
            pg8::gemm_phase<EpiResid, pg8::StaticOrder, TabNone, true, true>(lds, g, S, E, T);
        }
        GRID_BAR();
    }
    {
        WSP(ws); PTR(float, SS1, WS_SS1); float* out = p.out;
        int tidf = threadIdx.x; asm volatile("" : "+v"(tidf)); const int lane = tidf & 63;
        const int gw = bx * 8 + (tidf >> 6), NGW = G * 8;
        const float* fg = p.in[13];
        for (int mrow = gw; mrow < M; mrow += NGW) {
            float s = lane < 16 ? SS1[(size_t)mrow * 16 + lane] : 0.f;
            s = wave_sum(s);
            const float rs = 1.f / sqrtf(s * (1.f / 1024.f) + EPS);
            f32x4* xr = (f32x4*)(out + (size_t)mrow * DM) + lane;
#pragma unroll
            for (int j = 0; j < 4; ++j) { const f32x4 gg = *((const f32x4*)fg + lane + 64 * j); f32x4 v = xr[64 * j]; v = v * rs * gg; xr[64 * j] = v; }
        }
    }
}

extern "C" void kernel_launch(void* const* d_in, const int* in_sizes, int n_in, void* d_out, int out_size, void* d_ws, size_t ws_size, hipStream_t stream) {
    static int grid = 0;
    if (grid == 0) {
        if (n_in != 14 || ws_size < WS_END) { fprintf(stderr, "kernel_launch: unexpected n_in %d / ws_size %zu\n", n_in, ws_size); grid = -1; return; }
        int dev = 0, cus = 0, per_cu = 0;
        hipGetDevice(&dev); hipDeviceGetAttribute(&cus, hipDeviceAttributeMultiprocessorCount, dev);
        if (hipFuncSetAttribute((const void*)hybrid_fwd, hipFuncAttributeMaxDynamicSharedMemorySize, LDS_BYTES) != hipSuccess) { fprintf(stderr, "kernel_launch: hipFuncSetAttribute failed\n"); grid = -1; return; }
        hipOccupancyMaxActiveBlocksPerMultiprocessor(&per_cu, (const void*)hybrid_fwd, 512, LDS_BYTES);
        if (per_cu < 1) per_cu = 1;
        grid = cus * 1;
        fprintf(stderr, "kernel_launch: cus %d per_cu %d grid %d ws %zu\n", cus, per_cu, grid, ws_size);
        (void)hipGetLastError();
    }
    if (grid < 0) return;
    hipMemsetAsync((char*)d_ws + WS_CTL, 0, 32768, stream);
    Params p{};
    for (int i = 0; i < 14; ++i) p.in[i] = (const float*)d_in[i];
    p.out = (float*)d_out; p.ws = (unsigned char*)d_ws;
    for (int i = 0; i < 32; ++i) p.inv64[i] = 1.0f / powf(10000.0f, (float)i / 32.0f);
    for (int i = 0; i < 16; ++i) p.inv32[i] = 1.0f / powf(10000.0f, (float)i / 16.0f);
    void* args[] = {&p};
    hipError_t e = hipLaunchCooperativeKernel((const void*)hybrid_fwd, dim3(grid), dim3(512), args, LDS_BYTES, stream);
    if (e != hipSuccess) fprintf(stderr, "cooperative launch failed: %s (grid %d)\n", hipGetErrorString(e), grid);
}
```

```cpp
#include <hip/hip_runtime.h>
#include <hip/hip_cooperative_groups.h>
#include <cstdio>
#include <cstdint>
#include <cmath>
namespace cg = cooperative_groups;

namespace pg8 {
#define PG8_LAS __attribute__((address_space(3)))
typedef unsigned short bf16_t;
typedef short bf16x8 __attribute__((ext_vector_type(8)));
typedef float f32x4 __attribute__((ext_vector_type(4)));
typedef unsigned u32x4 __attribute__((ext_vector_type(4)));
constexpr int BM = 256, BK = 64, HALF = 128, HTB = HALF * BK * 2  , STAGE_BYTES = 8 * HTB, NXCD = 8, WGM = 8;

__host__ __device__ __forceinline__ int lds_byte(int r, int c) { const int st = (r >> 4) * 2 + (c >> 5), rr = r & 15, cc = c & 31, ob = rr * 64 + cc * 2; return st * 1024 + (ob ^ (((ob >> 9) & 1) << 5)); }
__host__ __device__ __forceinline__ void stage_rc(int b, int& R, int& C) { const int st = b / 1024, sb = b % 1024, swz = sb ^ (((sb >> 9) & 1) << 5); R = (st >> 1) * 16 + swz / 64; C = (st & 1) * 32 + (swz % 64) / 2; }
__host__ __device__ __forceinline__ int perm32(int rho) { const int n = rho >> 4, i = rho & 15; return 8 * (i >> 2) + 4 * n + (i & 3); }

struct Unit { int pm, pn; };
struct Gemm { const bf16_t* A; const bf16_t* Bt; int M, N, K, lda; };

struct StaticOrder {
    int nM, nN, nwg, G, c;
    __host__ __device__ void init(int M, int N, int G_, int c_) { nM = M / BM; nN = N / BM; nwg = nM * nN; G = G_; c = c_; }
    __host__ __device__ bool next(int i, Unit& u) const {
        const long L = (long)i * G + c; if (L >= nwg) return false;
        int wgid = (int)L; { const int q = nwg / NXCD, r = nwg % NXCD, xcd = wgid % NXCD, off = wgid / NXCD; wgid = (xcd < r ? xcd * (q + 1) : r * (q + 1) + (xcd - r) * q) + off; }
        const int nig = WGM * nN, gid = wgid / nig, fm = gid * WGM, gsz = (nM - fm) < WGM ? (nM - fm) : WGM;
        u.pm = fm + ((wgid % nig) % gsz); u.pn = (wgid % nig) / gsz; return true;
    }
    __device__ __forceinline__ void a_ready(const Unit&) const {}
    __device__ __forceinline__ void done(const Unit&) const {}
};

__device__ __forceinline__ unsigned cvt_pk_bf16(float lo, float hi) { unsigned r; asm volatile("v_cvt_pk_bf16_f32 %0, %1, %2" : "=v"(r) : "v"(lo), "v"(hi)); return r; }
template <class Epi, class Sched, class Tab, bool ALIGN_EPI = false, bool SP2 = false>
__device__ __forceinline__ void gemm_phase(PG8_LAS unsigned char* lds, const Gemm g, const Sched& S, const Epi& E, const Tab& T) {
    int tid_ = threadIdx.x; asm volatile("" : "+v"(tid_));
    const int tid = tid_, wid = __builtin_amdgcn_readfirstlane(tid >> 6), lane = tid & 63, wr = wid >> 2, wc = wid & 3, fr = lane & 15, fq = lane >> 4;
    const int K = g.K, nt = K / BK;
    unsigned voffA[2], voffB[2];
#pragma unroll
    for (int i = 0; i < 2; ++i) { int R, C; stage_rc(tid * 16 + i * 8192, R, C); const int Rb = Epi::PERM ? ((R & ~31) + perm32(R & 31)) : R;
        voffA[i] = (unsigned)(R * g.lda + C) * 2u; voffB[i] = (unsigned)(Rb * K + C) * 2u; }
    const size_t kstep = (size_t)(BK * 2);
    const size_t hstepA = (size_t)HALF * g.lda * 2, hstepB = (size_t)HALF * K * 2;
    const size_t tstepA = 2 * hstepA, tstepB = 2 * hstepB;
    const unsigned ldsw = (unsigned)wid * 1024u;
    const int aoff = lds_byte(wr * 64 + fr, fq * 8), boff = lds_byte(wc * 32 + fr, fq * 8);
#define PG8_SA(b, h) (((b) * 2 + (h)) * HTB)
#define PG8_SB(b, h) ((4 + (b) * 2 + (h)) * HTB)
#define PG8_STAGE(bufoff, gbase, voff) do { _Pragma("unroll") for (int _i = 0; _i < 2; ++_i) \
        __builtin_amdgcn_global_load_lds((const unsigned*)((const char*)(gbase) + (voff)[_i]), (PG8_LAS unsigned*)(lds + (bufoff) + ldsw + _i * 8192), 16, 0, 0); } while (0)
#define PG8_LDA(dst, b, h) do { _Pragma("unroll") for (int m = 0; m < 4; ++m) _Pragma("unroll") for (int k = 0; k < 2; ++k) dst[m][k] = *(const PG8_LAS bf16x8*)(lds + PG8_SA(b, h) + aoff + m * 2048 + k * 1024); } while (0)
#define PG8_LDB(dst, b, h) do { _Pragma("unroll") for (int n = 0; n < 2; ++n) _Pragma("unroll") for (int k = 0; k < 2; ++k) dst[n][k] = *(const PG8_LAS bf16x8*)(lds + PG8_SB(b, h) + boff + n * 2048 + k * 1024); } while (0)
#define PG8_MMA(ai, bj, At, Bt) do { __builtin_amdgcn_s_setprio(1); _Pragma("unroll") for (int m = 0; m < 4; ++m) _Pragma("unroll") for (int n = 0; n < 2; ++n) _Pragma("unroll") for (int k = 0; k < 2; ++k) \
        acc[ai][bj][m][n] = __builtin_amdgcn_mfma_f32_16x16x32_bf16(Bt[n][k], At[m][k], acc[ai][bj][m][n], 0, 0, 0); __builtin_amdgcn_s_setprio(0); } while (0)
#define PG8_WAIT_V(n) asm volatile("s_waitcnt vmcnt(" #n ")" ::: "memory")
#define PG8_WAIT_L(n) asm volatile("s_waitcnt lgkmcnt(" #n ")" ::: "memory")
#define PG8_BAR __builtin_amdgcn_s_barrier()
#define PG8_SCHED __builtin_amdgcn_sched_barrier(0)
    Unit cur, nxt; int ui = 0;
    if (!S.next(0, cur)) return;
    f32x4 acc[2][2][4][2];
#pragma unroll
    for (int a = 0; a < 2; ++a)
#pragma unroll
        for (int b = 0; b < 2; ++b)
#pragma unroll
            for (int m = 0; m < 4; ++m)
#pragma unroll
                for (int n = 0; n < 2; ++n) acc[a][b][m][n] = (f32x4){0.f, 0.f, 0.f, 0.f};
    bf16x8 At[4][2], B0[2][2], B1[2][2];
    const char* cA = (const char*)g.A + (size_t)cur.pm * tstepA; const char* cB = (const char*)g.Bt + (size_t)cur.pn * tstepB;
    T.fill(cur, (PG8_LAS float*)(lds + STAGE_BYTES));
    if constexpr (SP2) {
        PG8_STAGE(PG8_SB(0, 0), cB, voffB); PG8_STAGE(PG8_SB(0, 1), cB + hstepB, voffB); PG8_STAGE(PG8_SA(0, 0), cA, voffA); PG8_STAGE(PG8_SA(0, 1), cA + hstepA, voffA);
        if (wr == 1) PG8_BAR;
        PG8_WAIT_V(2); PG8_BAR;
        PG8_STAGE(PG8_SB(1, 0), cB + kstep, voffB); PG8_STAGE(PG8_SA(1, 0), cA + kstep, voffA); PG8_STAGE(PG8_SB(1, 1), cB + hstepB + kstep, voffB);
        PG8_WAIT_V(6); PG8_BAR;
    } else {
        PG8_STAGE(PG8_SB(0, 0), cB, voffB); PG8_STAGE(PG8_SA(0, 0), cA, voffA); PG8_STAGE(PG8_SB(0, 1), cB + hstepB, voffB); PG8_STAGE(PG8_SA(0, 1), cA + hstepA, voffA);
        if (wr == 1) PG8_BAR;
        PG8_WAIT_V(4); PG8_BAR;
        PG8_STAGE(PG8_SB(1, 0), cB + kstep, voffB); PG8_STAGE(PG8_SA(1, 0), cA + kstep, voffA); PG8_STAGE(PG8_SB(1, 1), cB + hstepB + kstep, voffB);
        PG8_WAIT_V(6); PG8_BAR;
    }
    for (;;) {
        const bool has_next = S.next(ui + 1, nxt);
        const char* nA = has_next ? (const char*)g.A + (size_t)nxt.pm * tstepA : cA; const char* nB = has_next ? (const char*)g.Bt + (size_t)nxt.pn * tstepB : cB;
        for (int t = 0; t < nt; t += 2) {
            const bool last = (t == nt - 2);
            const char* a1 = cA + (size_t)(t + 1) * kstep;
            const char* a2 = last ? nA : cA + (size_t)(t + 2) * kstep; const char* b2 = last ? nB : cB + (size_t)(t + 2) * kstep;
            const char* a3 = a2 + kstep; const char* b3 = b2 + kstep;
            if (last && has_next) T.fill(nxt, (PG8_LAS float*)(lds + STAGE_BYTES + ((ui + 1) & 1) * 1024));
            if constexpr (SP2) {
            PG8_LDB(B0, 0, 0); PG8_LDB(B1, 0, 1); PG8_SCHED; PG8_LDA(At, 0, 0); PG8_STAGE(PG8_SA(1, 1), a1 + hstepA, voffA);
            PG8_WAIT_V(8); PG8_WAIT_L(0); PG8_BAR; PG8_MMA(0, 0, At, B0); PG8_MMA(0, 1, At, B1); PG8_BAR; PG8_SCHED;
            PG8_LDA(At, 0, 1); PG8_STAGE(PG8_SB(0, 0), b2, voffB); PG8_STAGE(PG8_SB(0, 1), b2 + hstepB, voffB); PG8_STAGE(PG8_SA(0, 0), a2, voffA);
            PG8_WAIT_V(8); PG8_WAIT_L(0); PG8_BAR; PG8_MMA(1, 0, At, B0); PG8_MMA(1, 1, At, B1); PG8_BAR; PG8_SCHED;
            PG8_LDB(B0, 1, 0); PG8_LDB(B1, 1, 1); PG8_SCHED; PG8_LDA(At, 1, 0); PG8_STAGE(PG8_SA(0, 1), a2 + hstepA, voffA);
            PG8_WAIT_V(8); PG8_WAIT_L(0); PG8_BAR; PG8_MMA(0, 0, At, B0); PG8_MMA(0, 1, At, B1); PG8_BAR; PG8_SCHED;
            PG8_LDA(At, 1, 1); PG8_STAGE(PG8_SB(1, 0), b3, voffB); PG8_STAGE(PG8_SB(1, 1), b3 + hstepB, voffB); PG8_STAGE(PG8_SA(1, 0), a3, voffA);
            PG8_WAIT_V(8); PG8_WAIT_L(0); PG8_BAR; PG8_MMA(1, 0, At, B0); PG8_MMA(1, 1, At, B1); PG8_BAR; PG8_SCHED;
            } else {
            PG8_LDB(B0, 0, 0); PG8_SCHED; PG8_LDA(At, 0, 0); PG8_STAGE(PG8_SA(1, 1), a1 + hstepA, voffA);
            PG8_WAIT_L(8); PG8_BAR; PG8_WAIT_L(0); PG8_MMA(0, 0, At, B0); PG8_BAR; PG8_SCHED;
            PG8_LDB(B1, 0, 1); PG8_STAGE(PG8_SB(0, 0), b2, voffB);
            PG8_BAR; PG8_WAIT_L(0); PG8_MMA(0, 1, At, B1); PG8_BAR;
            PG8_LDA(At, 0, 1); PG8_STAGE(PG8_SA(0, 0), a2, voffA);
            PG8_BAR; PG8_WAIT_L(0); PG8_MMA(1, 0, At, B0); PG8_BAR; PG8_SCHED;
            PG8_STAGE(PG8_SB(0, 1), b2 + hstepB, voffB);
            PG8_WAIT_V(6); PG8_BAR; PG8_MMA(1, 1, At, B1); PG8_BAR;
            PG8_LDB(B0, 1, 0); PG8_SCHED; PG8_LDA(At, 1, 0); PG8_STAGE(PG8_SA(0, 1), a2 + hstepA, voffA);
            PG8_WAIT_L(8); PG8_BAR; PG8_WAIT_L(0); PG8_MMA(0, 0, At, B0); PG8_BAR; PG8_SCHED;
            PG8_LDB(B1, 1, 1); PG8_STAGE(PG8_SB(1, 0), b3, voffB);
            PG8_BAR; PG8_WAIT_L(0); PG8_MMA(0, 1, At, B1); PG8_BAR;
            PG8_LDA(At, 1, 1); PG8_STAGE(PG8_SA(1, 0), a3, voffA);
            PG8_BAR; PG8_WAIT_L(0); PG8_MMA(1, 0, At, B0); PG8_BAR; PG8_SCHED;
            PG8_STAGE(PG8_SB(1, 1), b3 + hstepB, voffB);
            PG8_WAIT_V(6); PG8_BAR; PG8_MMA(1, 1, At, B1); PG8_BAR;
            }
        }
        if constexpr (ALIGN_EPI) { if (wr == 0) PG8_BAR; }
        E(acc, cur, wr, wc, fr, fq, (const PG8_LAS float*)(lds + STAGE_BYTES + (ui & 1) * 1024));
        if (!has_next) break;
#pragma unroll
        for (int a = 0; a < 2; ++a)
#pragma unroll
            for (int b = 0; b < 2; ++b)
#pragma unroll
                for (int m = 0; m < 4; ++m)
#pragma unroll
                    for (int n = 0; n < 2; ++n) acc[a][b][m][n] = (f32x4){0.f, 0.f, 0.f, 0.f};
        cur = nxt; cA = nA; cB = nB; ++ui;
        if constexpr (ALIGN_EPI) { if (wr == 1) PG8_BAR; }
    }
    PG8_WAIT_V(0);
    if constexpr (!ALIGN_EPI) { if (wr == 0) PG8_BAR; }
    PG8_BAR;
#undef PG8_SA
#undef PG8_SB
#undef PG8_STAGE
#undef PG8_LDA
#undef PG8_LDB
#undef PG8_MMA
#undef PG8_WAIT_V
#undef PG8_WAIT_L
#undef PG8_BAR
#undef PG8_SCHED
}
}

#define LAS __attribute__((address_space(3)))
typedef unsigned short bf16_t;
typedef short bf16x8 __attribute__((ext_vector_type(8)));
typedef float f32x4 __attribute__((ext_vector_type(4)));
typedef float f32x16 __attribute__((ext_vector_type(16)));
typedef unsigned u32x4 __attribute__((ext_vector_type(4)));
typedef unsigned u32x2 __attribute__((ext_vector_type(2)));

constexpr int BATCH = 2, SEQ = 8192, M = BATCH * SEQ, DM = 1024, NIN = 2560, FF = 4096;
constexpr float LOG2E = 1.4426950408889634f;
constexpr float SC_A = 0.125f * LOG2E, SC_B = 0.10206207261596575f * LOG2E, SC_C = 0.17677669529663687f * LOG2E;
constexpr float EPS = 1e-6f;

constexpr size_t MiB = 1u << 20;
constexpr size_t WS_CTL = 0;
constexpr size_t WS_COS64 = 1 * MiB, WS_SIN64 = 2 * MiB, WS_COS32 = 3 * MiB, WS_SIN32 = 3 * MiB + 512 * 1024;
constexpr size_t WS_SS1 = 4 * MiB, WS_SS2 = 5 * MiB, WS_LSE = 6 * MiB, WS_LAM = 7 * MiB + 512 * 1024;
constexpr size_t WS_W = 8 * MiB, W_LAYER = 24 * MiB;
constexpr size_t W_IN = 0, W_UQ = 5 * MiB, W_UKV = 5 * MiB + 768 * 1024, W_O = 6 * MiB, W_UP = 8 * MiB, W_DN = 16 * MiB;
constexpr size_t WS_XB = 56 * MiB, WS_OA = 56 * MiB, WS_MIX = 92 * MiB, WS_P = 124 * MiB, WS_QB = 204 * MiB, WS_KVB = 228 * MiB, WS_H = 124 * MiB, WS_END = 252 * MiB;
constexpr int LDS_BYTES = 147456;
constexpr int LDS_TAB = 131072, LDS_MISC = 131072 + 4096;

__device__ __forceinline__ float bf_lo(unsigned w) { return __uint_as_float(w << 16); }
__device__ __forceinline__ float bf_hi(unsigned w) { return __uint_as_float(w & 0xffff0000u); }
template <int PAT> __device__ __forceinline__ float swz(float v) { return __builtin_bit_cast(float, __builtin_amdgcn_ds_swizzle(__builtin_bit_cast(int, v), PAT)); }
__device__ __forceinline__ float xsum32(float v) { auto rr = __builtin_amdgcn_permlane32_swap(__float_as_uint(v), __float_as_uint(v), false, false); return __uint_as_float(rr[0]) + __uint_as_float(rr[1]); }
__device__ __forceinline__ u32x4 pack8(f32x4 a, f32x4 b) {
    u32x4 w; w.x = pg8::cvt_pk_bf16(a[0], a[1]); w.y = pg8::cvt_pk_bf16(a[2], a[3]); w.z = pg8::cvt_pk_bf16(b[0], b[1]); w.w = pg8::cvt_pk_bf16(b[2], b[3]); return w;
}
__device__ __forceinline__ void rope8(f32x4& a, f32x4& b, f32x4 cs, f32x4 sn) {
    float x, y;
    x = a[0]; y = a[1]; a[0] = x * cs[0] - y * sn[0]; a[1] = x * sn[0] + y * cs[0];
    x = a[2]; y = a[3]; a[2] = x * cs[1] - y * sn[1]; a[3] = x * sn[1] + y * cs[1];
    x = b[0]; y = b[1]; b[0] = x * cs[2] - y * sn[2]; b[1] = x * sn[2] + y * cs[2];
    x = b[2]; y = b[3]; b[2] = x * cs[3] - y * sn[3]; b[3] = x * sn[3] + y * cs[3];
}

struct TabNone { __device__ __forceinline__ void fill(const pg8::Unit&, LAS float*) const {} };
struct TabSS {
    const float* ss;
    __device__ __forceinline__ void fill(const pg8::Unit& u, LAS float* tab) const {
        int tid = threadIdx.x; asm volatile("" : "+v"(tid));
        if (tid < 256) {
            const f32x4* p = (const f32x4*)(ss + (size_t)(u.pm * 256 + tid) * 16);
            f32x4 s = p[0]; s = s + p[1]; s = s + p[2]; s = s + p[3];
            const float t = (s[0] + s[1]) + (s[2] + s[3]);
            tab[tid] = __builtin_amdgcn_rsqf(t * (1.f / 1024.f) + EPS);
        }
    }
};
template <int NCOLS> struct TabRows {
    const bf16_t* base; int pitch;
    __device__ __forceinline__ void fill(const pg8::Unit& u, LAS float* tab) const {
        int tid = threadIdx.x; asm volatile("" : "+v"(tid));
        const u32x4* p = (const u32x4*)(base + (size_t)(u.pm * 256 + (tid >> 1)) * pitch + (tid & 1) * (NCOLS / 2));
        float s = 0.f;
#pragma unroll 4
        for (int i = 0; i < NCOLS / 16; ++i) {
            const u32x4 v = p[i];
            s += bf_lo(v.x) * bf_lo(v.x) + bf_hi(v.x) * bf_hi(v.x) + bf_lo(v.y) * bf_lo(v.y) + bf_hi(v.y) * bf_hi(v.y)
               + bf_lo(v.z) * bf_lo(v.z) + bf_hi(v.z) * bf_hi(v.z) + bf_lo(v.w) * bf_lo(v.w) + bf_hi(v.w) * bf_hi(v.w);
        }
        s += swz<0x041f>(s);
        if (!(tid & 1)) tab[tid >> 1] = __builtin_amdgcn_rsqf(s * (1.f / NCOLS) + EPS);
    }
};

#define EPI_ROWS_BEGIN _Pragma("unroll") for (int ai = 0; ai < 2; ++ai) _Pragma("unroll") for (int m = 0; m < 4; ++m) { const int rl = ai * 128 + wr * 64 + m * 16 + fr; const int row = u.pm * 256 + rl;
#define EPI_ROWS_END }

struct EpiInProj {
    static constexpr bool PERM = true;
    bf16_t* P; const float* c64; const float* s64; const float* c32; const float* s32; int pn0;
    __device__ __forceinline__ void operator()(const f32x4 (&acc)[2][2][4][2], const pg8::Unit& u, int wr, int wc, int fr, int fq, const LAS float* tab) const {
#pragma unroll
        for (int bj = 0; bj < 2; ++bj) {
            const int cb = (u.pn + pn0) * 256 + bj * 128 + wc * 32, c0 = cb + 8 * fq;
            int typ = 0; float sc = 1.f;
            if (cb < 384) { typ = 1; sc = SC_A; } else if (cb < 768) typ = 1; else if (cb < 1664) typ = 0; else if (cb < 1696) typ = 2;
            else if (cb < 1792) typ = 0; else if (cb < 2048) { typ = 2; sc = SC_C; } else if (cb < 2304) typ = 2;
            EPI_ROWS_BEGIN
                const float rs = tab[rl] * sc;
                f32x4 v0 = acc[ai][bj][m][0] * rs, v1 = acc[ai][bj][m][1] * rs;
                if (typ == 1) { const int o = (row & (SEQ - 1)) * 32 + ((c0 & 63) >> 1); rope8(v0, v1, *(const f32x4*)(c64 + o), *(const f32x4*)(s64 + o)); }
                else if (typ == 2) { const int o = (row & (SEQ - 1)) * 16 + ((c0 & 31) >> 1); rope8(v0, v1, *(const f32x4*)(c32 + o), *(const f32x4*)(s32 + o)); }
                *(u32x4*)(P + (size_t)row * NIN + c0) = pack8(v0, v1);
            EPI_ROWS_END
        }
    }
};
struct EpiUq {
    static constexpr bool PERM = true;
    bf16_t* Q; const float* c32; const float* s32;
    __device__ __forceinline__ void operator()(const f32x4 (&acc)[2][2][4][2], const pg8::Unit& u, int wr, int wc, int fr, int fq, const LAS float* tab) const {
#pragma unroll
        for (int bj = 0; bj < 2; ++bj) {
            const int c0 = u.pn * 256 + bj * 128 + wc * 32 + 8 * fq;
            const bool ok = c0 < 576; const int h = c0 / 96, p = c0 - 96 * h; const bool rp = ok && p >= 64; const int i0 = rp ? ((p - 64) >> 1) : 0;
            EPI_ROWS_BEGIN
                const float rs = tab[rl] * SC_B;
                f32x4 v0 = acc[ai][bj][m][0] * rs, v1 = acc[ai][bj][m][1] * rs;
                const int o = (row & (SEQ - 1)) * 16 + i0;
                f32x4 cs = *(const f32x4*)(c32 + o), sn = *(const f32x4*)(s32 + o);
                if (!rp) { cs = (f32x4){1.f, 1.f, 1.f, 1.f}; sn = (f32x4){0.f, 0.f, 0.f, 0.f}; }
                rope8(v0, v1, cs, sn);
                if (ok) *(u32x4*)(Q + (size_t)row * 768 + c0) = pack8(v0, v1);
            EPI_ROWS_END
        }
    }
};
template <int ACT  > struct EpiScaled {
    static constexpr bool PERM = true;
    bf16_t* O; int ldc;
    __device__ __forceinline__ void operator()(const f32x4 (&acc)[2][2][4][2], const pg8::Unit& u, int wr, int wc, int fr, int fq, const LAS float* tab) const {
        EPI_ROWS_BEGIN
            const float rs = tab[rl];
#pragma unroll
            for (int bj = 0; bj < 2; ++bj) {
                const int c0 = u.pn * 256 + bj * 128 + wc * 32 + 8 * fq;
                f32x4 v0 = acc[ai][bj][m][0] * rs, v1 = acc[ai][bj][m][1] * rs;
                if (ACT == 1) {
#pragma unroll
                    for (int k = 0; k < 4; ++k) { const float a = fmaxf(v0[k], 0.f), b = fmaxf(v1[k], 0.f); v0[k] = a * a; v1[k] = b * b; }
                }
                *(u32x4*)(O + (size_t)row * ldc + c0) = pack8(v0, v1);
            }
        EPI_ROWS_END
    }
};
struct EpiResid {
    static constexpr bool PERM = true;
    const float* xin; float* xout; bf16_t* xb; float* ss;
    __device__ __forceinline__ void operator()(const f32x4 (&acc)[2][2][4][2], const pg8::Unit& u, int wr, int wc, int fr, int fq, const LAS float*) const {
        EPI_ROWS_BEGIN
            float sq = 0.f;
#pragma unroll
            for (int bj = 0; bj < 2; ++bj) {
                const size_t off = (size_t)row * DM + u.pn * 256 + bj * 128 + wc * 32 + 8 * fq;
                const f32x4 r0 = *(const f32x4*)(xin + off), r1 = *(const f32x4*)(xin + off + 4);
                const f32x4 v0 = r0 + acc[ai][bj][m][0], v1 = r1 + acc[ai][bj][m][1];
                *(f32x4*)(xout + off) = v0; *(f32x4*)(xout + off + 4) = v1;
                *(u32x4*)(xb + off) = pack8(v0, v1);
                sq += (v0[0] * v0[0] + v0[1] * v0[1]) + (v0[2] * v0[2] + v0[3] * v0[3]) + (v1[0] * v1[0] + v1[1] * v1[1]) + (v1[2] * v1[2] + v1[3] * v1[3]);
            }
            sq += swz<0x401f>(sq); sq = xsum32(sq);
            if (fq == 0) ss[(size_t)row * 16 + u.pn * 4 + wc] = sq;
        EPI_ROWS_END
    }
};

struct AttnBufs { const bf16_t* P; const bf16_t* QB; const bf16_t* KVB; bf16_t* OA; float* LSE; bf16_t* MIX; const float* subg; float lam; float oml; };
namespace att {
constexpr int KSTR = 1040, VOFF = 12544, VDH = 4160, BUFB = 20992, OST = 3 * BUFB, OSTW = 4608;
constexpr float NEG = -1e30f;
typedef short v4i16_t __attribute__((ext_vector_type(4)));
__device__ __forceinline__ int crow(int r, int hi) { return (r & 3) + 8 * (r >> 2) + 4 * hi; }
__device__ __forceinline__ v4i16_t vtr(const LAS unsigned char* p) { return __builtin_amdgcn_ds_read_tr16_b64_v4i16((LAS v4i16_t*)p); }
__device__ __forceinline__ float swapmax(float v) { auto rr = __builtin_amdgcn_permlane32_swap(__float_as_uint(v), __float_as_uint(v), false, false); return fmaxf(__uint_as_float(rr[0]), __uint_as_float(rr[1])); }
__device__ __forceinline__ float swapsum(float v) { auto rr = __builtin_amdgcn_permlane32_swap(__float_as_uint(v), __float_as_uint(v), false, false); return __uint_as_float(rr[0]) + __uint_as_float(rr[1]); }

__device__ __forceinline__ float max3f(float a, float b, float c) { float r; asm("v_max3_f32 %0, %1, %2, %3" : "=v"(r) : "v"(a), "v"(b), "v"(c)); return r; }
template <int TYPE, int DQ, int NMAP, int NQF, int NDS, bool BAND, int MPSEL>
__device__ __forceinline__ void att_qksm(const LAS unsigned char* Kb, const int kt, const int qw0, const int r32, const int hi, const int kofs,
                                         const bf16x8 (&qf)[NQF], f32x16 (&o)[NMAP][2], float (&mref)[NMAP], float (&lrun)[NMAP], f32x16 (&negm)[NMAP], const bool first, u32x4 (&pw)[NMAP][4]) {
    const int kmin = 64 * kt, kmax = kmin + 63;
    {
        bool needmask = kmax > qw0; if (BAND) needmask = needmask || (kmin + 128 < qw0 + 31);
#pragma unroll
        for (int mp = 0; mp < NMAP; ++mp) {
            if (MPSEL >= 0 && mp != MPSEL) continue;
            f32x16 s0, s1;
            if (NMAP == 1) { s0 = negm[mp]; s1 = negm[mp]; }
            else {
#pragma unroll
                for (int r = 0; r < 16; ++r) { s0[r] = -mref[mp]; s1[r] = s0[r]; }
            }
            constexpr int KH = NDS >= 4 ? NDS / 2 : NDS;
#pragma unroll
            for (int d1 = 0; d1 < NDS; d1 += KH) {
                bf16x8 kf0[KH], kf1[KH];
#pragma unroll
                for (int ds = 0; ds < KH; ++ds) {
                    kf0[ds] = *(const LAS bf16x8*)(Kb + kofs + (2 * (mp * NDS + d1 + ds)) * KSTR);
                    kf1[ds] = *(const LAS bf16x8*)(Kb + kofs + (2 * (mp * NDS + d1 + ds)) * KSTR + 512);
                }
                asm volatile("" ::: "memory");
#pragma unroll
                for (int ds = 0; ds < KH; ++ds) {
                    s0 = __builtin_amdgcn_mfma_f32_32x32x16_bf16(kf0[ds], qf[mp * NDS + d1 + ds], s0, 0, 0, 0);
                    s1 = __builtin_amdgcn_mfma_f32_32x32x16_bf16(kf1[ds], qf[mp * NDS + d1 + ds], s1, 0, 0, 0);
                }
            }
            if (needmask) {
                const int qpos = qw0 + r32;
#pragma unroll
                for (int r = 0; r < 16; ++r) {
                    const int kv0 = kmin + crow(r, hi), kv1 = kv0 + 32;
                    bool ok0 = kv0 <= qpos, ok1 = kv1 <= qpos;
                    if (BAND) { ok0 = ok0 && (kv0 + 128 >= qpos); ok1 = ok1 && (kv1 + 128 >= qpos); }
                    s0[r] = ok0 ? s0[r] : NEG; s1[r] = ok1 ? s1[r] : NEG;
                }
            }
            float ra = max3f(s0[0], s0[1], s1[0]), rb = max3f(s0[2], s0[3], s1[1]); ra = max3f(ra, s1[2], s1[3]);
#pragma unroll
            for (int r = 4; r < 16; r += 4) { ra = max3f(ra, s0[r], s0[r + 1]); rb = max3f(rb, s0[r + 2], s0[r + 3]); ra = max3f(ra, s1[r], s1[r + 1]); rb = max3f(rb, s1[r + 2], s1[r + 3]); }
            const float rm = swapmax(fmaxf(ra, rb));
            const float dl = first ? (rm > -1e29f ? rm : 0.f) : (rm > 8.f ? rm : 0.f);
            if (__any(dl != 0.f)) {
                mref[mp] += dl;
                const float f = __builtin_amdgcn_exp2f(-dl);
                lrun[mp] *= f;
#pragma unroll
                for (int r = 0; r < 16; ++r) { s0[r] -= dl; s1[r] -= dl; o[mp][0][r] *= f; o[mp][1][r] *= f; if (NMAP == 1) negm[mp][r] = -mref[mp]; }
            }
            float ps0 = 0.f, ps1 = 0.f;
#pragma unroll
            for (int r = 0; r < 16; ++r) { s0[r] = __builtin_amdgcn_exp2f(s0[r]); s1[r] = __builtin_amdgcn_exp2f(s1[r]); ps0 += s0[r]; ps1 += s1[r]; }
            lrun[mp] += ps0 + ps1;
#pragma unroll
            for (int k = 0; k < 2; ++k) {
                pw[mp][k]     = (u32x4){pg8::cvt_pk_bf16(s0[8 * k], s0[8 * k + 1]), pg8::cvt_pk_bf16(s0[8 * k + 2], s0[8 * k + 3]), pg8::cvt_pk_bf16(s0[8 * k + 4], s0[8 * k + 5]), pg8::cvt_pk_bf16(s0[8 * k + 6], s0[8 * k + 7])};
                pw[mp][2 + k] = (u32x4){pg8::cvt_pk_bf16(s1[8 * k], s1[8 * k + 1]), pg8::cvt_pk_bf16(s1[8 * k + 2], s1[8 * k + 3]), pg8::cvt_pk_bf16(s1[8 * k + 4], s1[8 * k + 5]), pg8::cvt_pk_bf16(s1[8 * k + 6], s1[8 * k + 7])};
            }
        }
    }
}
template <int NMAP, int MPSEL>
__device__ __forceinline__ void att_pv(const LAS unsigned char* Vb, f32x16 (&o)[NMAP][2], const u32x4 (&pw)[NMAP][4]) {
    constexpr int KB = 2;
#pragma unroll
    for (int kh = 0; kh < 4 / KB; ++kh) {
        v4i16_t vlo[KB][2], vhh[KB][2];
#pragma unroll
        for (int k2 = 0; k2 < KB; ++k2)
#pragma unroll
            for (int d0 = 0; d0 < 2; ++d0) { vlo[k2][d0] = vtr(Vb + d0 * VDH + (KB * kh + k2) * 1024); vhh[k2][d0] = vtr(Vb + d0 * VDH + (KB * kh + k2) * 1024 + 512); }
        asm volatile("" ::: "memory");
#pragma unroll
        for (int k2 = 0; k2 < KB; ++k2)
#pragma unroll
            for (int d0 = 0; d0 < 2; ++d0) {
                const bf16x8 vf = (bf16x8){vlo[k2][d0][0], vlo[k2][d0][1], vlo[k2][d0][2], vlo[k2][d0][3], vhh[k2][d0][0], vhh[k2][d0][1], vhh[k2][d0][2], vhh[k2][d0][3]};
#pragma unroll
                for (int mp = 0; mp < NMAP; ++mp) if (MPSEL < 0 || mp == MPSEL) o[mp][d0] = __builtin_amdgcn_mfma_f32_32x32x16_bf16(vf, __builtin_bit_cast(bf16x8, pw[mp][KB * kh + k2]), o[mp][d0], 0, 0, 0);
            }
    }
}

template <int TYPE>
__device__ __forceinline__ void attn_unit(LAS unsigned char* lds, const AttnBufs& A, int b, int h, int qb, int cfg, int res) {
    constexpr int DQ = TYPE == 0 ? 64 : (TYPE == 1 ? 96 : 32), NMAP = TYPE == 2 ? 2 : 1, NCH = NMAP * DQ / 8, NQF = NMAP * DQ / 16, NDS = DQ / 16;
    constexpr int NC1 = TYPE == 1 ? 8 : NCH, NKP = NCH * 64;
    constexpr bool BAND = TYPE == 0;
    int tid_ = threadIdx.x; asm volatile("" : "+v"(tid_));
    const int tid = tid_, lane = tid & 63, r32 = lane & 31, hi = lane >> 5;
    const int wid = __builtin_amdgcn_readfirstlane(tid >> 6);
    const int dil = (TYPE == 0) ? (cfg == 0 ? 1 : (cfg == 1 ? 4 : 16)) : 1;
    const long rowbase = (long)b * SEQ + res;
    const bf16_t *Qp, *K1p, *K2p, *Vp; int pQ, pK1, pK2, pV;
    if (TYPE == 0) { Qp = A.P + h * 64; pQ = NIN; K1p = A.P + 384 + h * 64; pK1 = NIN; K2p = K1p; pK2 = NIN; Vp = A.P + 768 + h * 64; pV = NIN; }
    else if (TYPE == 1) { Qp = A.QB + h * 96; pQ = 768; K1p = A.KVB + h * 128; pK1 = 768; K2p = A.P + 1664; pK2 = NIN; Vp = A.KVB + h * 128 + 64; pV = 768; }
    else { Qp = A.P + 1792 + h * 64; pQ = NIN; K1p = A.P + 2048 + h * 64; pK1 = NIN; K2p = K1p; pK2 = NIN; Vp = A.P + 2304 + h * 64; pV = NIN; }
    const int q0 = qb * 256, qw0 = q0 + wid * 32;
    const int kt_lo = BAND ? (qb > 0 ? 4 * qb - 2 : 0) : 0, kt_hi = 4 * qb + 4;
    bf16x8 qf[NQF];
    { const bf16_t* qrow = Qp + (rowbase + (long)dil * (qw0 + r32)) * pQ + hi * 8;
#pragma unroll
      for (int f = 0; f < NQF; ++f) qf[f] = *(const bf16x8*)(qrow + f * 16); }
    const bool k1ok = (NKP > 512) && (tid + 512 < NKP);
    const int p1 = k1ok ? tid + 512 : tid;
    const int krow0 = tid / NCH, kch0 = tid % NCH, krow1 = p1 / NCH, kch1 = p1 % NCH;
    const int vrow = tid >> 3, vch = tid & 7;
    const int kdst0 = kch0 * KSTR + krow0 * 16, kdst1 = kch1 * KSTR + krow1 * 16, vdst = VOFF + (vch >> 2) * VDH + vrow * 64 + (vch & 3) * 16;
    u32x4 kra0, kra1 = (u32x4){0u, 0u, 0u, 0u}, vra, krb0, krb1 = (u32x4){0u, 0u, 0u, 0u}, vrb;
    const char* kp0_; const char* kp1_; const char* vp_; long st0_, st1_, stv_;
    { const long g = rowbase + (long)dil * (64 * kt_lo + krow0);
      if (kch0 < NC1) { kp0_ = (const char*)(K1p + g * pK1 + kch0 * 8); st0_ = (long)dil * 64 * pK1 * 2; } else { kp0_ = (const char*)(K2p + g * pK2 + (kch0 - NC1) * 8); st0_ = (long)dil * 64 * pK2 * 2; } }
    { const long g = rowbase + (long)dil * (64 * kt_lo + krow1);
      if (kch1 < NC1) { kp1_ = (const char*)(K1p + g * pK1 + kch1 * 8); st1_ = (long)dil * 64 * pK1 * 2; } else { kp1_ = (const char*)(K2p + g * pK2 + (kch1 - NC1) * 8); st1_ = (long)dil * 64 * pK2 * 2; } }
    { const long g = rowbase + (long)dil * (64 * kt_lo + vrow); vp_ = (const char*)(Vp + g * pV + vch * 8); stv_ = (long)dil * 64 * pV * 2; }
#define ATT_LOADT(kt, kr0, kr1, vr) do { \
        kr0 = *(const u32x4*)kp0_; kp0_ += st0_; \
        if (NKP > 512) { kr1 = *(const u32x4*)kp1_; kp1_ += st1_; } \
        vr = *(const u32x4*)vp_; vp_ += stv_; } while (0)
#define ATT_STORET(bo, kr0, kr1, vr) do { *(LAS u32x4*)(lds + (bo) + kdst0) = kr0; if (k1ok) *(LAS u32x4*)(lds + (bo) + kdst1) = kr1; *(LAS u32x4*)(lds + (bo) + vdst) = vr; } while (0)
    f32x16 o[NMAP][2], negm[NMAP]; float mrun[NMAP], lrun[NMAP]; bool started = false;
#pragma unroll
    for (int mp = 0; mp < NMAP; ++mp) { mrun[mp] = 0.f; lrun[mp] = 0.f;
#pragma unroll
        for (int r = 0; r < 16; ++r) negm[mp][r] = 0.f;
#pragma unroll
        for (int d0 = 0; d0 < 2; ++d0)
#pragma unroll
            for (int r = 0; r < 16; ++r) o[mp][d0][r] = 0.f; }
    const int kofs = hi * KSTR + r32 * 16;
    const int vofs = VOFF + ((lane >> 4) & 1) * 32 + (lane & 3) * 8 + (4 * hi + ((lane & 15) >> 2)) * 64;
    const bool lag = (NMAP == 1) && wid >= 4;
    int bp = 0, bc = 0, bn = BUFB;
#define ATT_ROT() do { bp = bc; bc = bn; bn = (bn == 2 * BUFB) ? 0 : bn + BUFB; } while (0)
#define ATT_LOOP(STEP) \
    for (int kt = kt_lo; kt < kt_hi; kt += 2) {     \
        const bool more = kt + 2 < kt_hi; \
        const int ktn = more ? kt + 2 : kt;            \
        ATT_LOADT(ktn, kra0, kra1, vra); \
        STEP(kt); \
        ATT_STORET(bn, krb0, krb1, vrb); \
        __syncthreads(); \
        ATT_ROT(); \
        ATT_LOADT(ktn + 1, krb0, krb1, vrb); \
        STEP(kt + 1); \
        if (more) ATT_STORET(bn, kra0, kra1, vra); \
        __syncthreads(); \
        ATT_ROT(); \
    }
#define ATT_ACTIVE(kt_) ((64 * (kt_) <= qw0 + 31) && (!BAND || (64 * (kt_) + 63 + 128 >= qw0)))
#define ATT_QKSM(kt_, MP, pw_) att_qksm<TYPE, DQ, NMAP, NQF, NDS, BAND, MP>(lds + bc, (kt_), qw0, r32, hi, kofs, qf, o, mrun, lrun, negm, first_, pw_)
#define ATT_STEP_N(kt_) do { if (ATT_ACTIVE(kt_)) { const bool first_ = !started; started = true; u32x4 pw[NMAP][4]; \
            if (NMAP == 1) { ATT_QKSM(kt_, -1, pw); att_pv<NMAP, -1>(lds + bc + vofs, o, pw); } \
            else { ATT_QKSM(kt_, 0, pw); att_pv<NMAP, 0>(lds + bc + vofs, o, pw); ATT_QKSM(kt_, NMAP - 1, pw); att_pv<NMAP, NMAP - 1>(lds + bc + vofs, o, pw); } } } while (0)
#define ATT_STEP_L(kt_) do { if (pend) att_pv<NMAP, -1>(lds + bp + vofs, o, pwl); pend = false; \
        if (ATT_ACTIVE(kt_)) { const bool first_ = !started; started = true; ATT_QKSM(kt_, -1, pwl); pend = true; } } while (0)
    ATT_LOADT(kt_lo, kra0, kra1, vra); ATT_LOADT(kt_lo + 1, krb0, krb1, vrb); ATT_STORET(0, kra0, kra1, vra);
    __syncthreads();
    if (!lag) {
        ATT_LOOP(ATT_STEP_N)
    } else {
        u32x4 pwl[NMAP][4]; bool pend = false;
        ATT_LOOP(ATT_STEP_L)
        if (pend) att_pv<NMAP, -1>(lds + bp + vofs, o, pwl);
    }
    __syncthreads();
#undef ATT_STEP_N
#undef ATT_ACTIVE
#undef ATT_QKSM
#undef ATT_STEP_L
#undef ATT_LOOP
#undef ATT_ROT
#undef ATT_LOADT
#undef ATT_STORET
    float linv[NMAP], ltot[NMAP];
#pragma unroll
    for (int mp = 0; mp < NMAP; ++mp) { ltot[mp] = swapsum(lrun[mp]); linv[mp] = 1.f / ltot[mp]; }
    f32x16 val[2];
    if (TYPE == 2) {
        float sq = 0.f;
#pragma unroll
        for (int d0 = 0; d0 < 2; ++d0)
#pragma unroll
            for (int r = 0; r < 16; ++r) { const float v = o[0][d0][r] * linv[0] - A.lam * (o[NMAP - 1][d0][r] * linv[NMAP - 1]); val[d0][r] = v; sq += v * v; }
        sq = swapsum(sq);
        const float rs = __builtin_amdgcn_rsqf(sq * (1.f / 64.f) + 1e-5f) * A.oml;
#pragma unroll
        for (int d0 = 0; d0 < 2; ++d0)
#pragma unroll
            for (int g4 = 0; g4 < 4; ++g4) { const f32x4 gg = *(const f32x4*)(A.subg + 32 * d0 + 8 * g4 + 4 * hi);
#pragma unroll
                for (int k = 0; k < 4; ++k) val[d0][4 * g4 + k] *= rs * gg[k]; }
    } else {
#pragma unroll
        for (int d0 = 0; d0 < 2; ++d0)
#pragma unroll
            for (int r = 0; r < 16; ++r) val[d0][r] = o[0][d0][r] * linv[0];
    }
    LAS unsigned char* stg = lds + OST + wid * OSTW;
#pragma unroll
    for (int d0 = 0; d0 < 2; ++d0)
#pragma unroll
        for (int g4 = 0; g4 < 4; ++g4) {
            u32x2 w; w.x = pg8::cvt_pk_bf16(val[d0][4 * g4], val[d0][4 * g4 + 1]); w.y = pg8::cvt_pk_bf16(val[d0][4 * g4 + 2], val[d0][4 * g4 + 3]);
            *(LAS u32x2*)(stg + r32 * 144 + (32 * d0 + 8 * g4 + 4 * hi) * 2) = w;
        }
    bf16_t* Out; int pO;
    if (TYPE == 0) { Out = A.OA + (size_t)cfg * M * 384 + h * 64; pO = 384; }
    else if (TYPE == 1) { Out = A.MIX + 384 + h * 64; pO = DM; }
    else { Out = A.MIX + 768 + h * 64; pO = DM; }
#pragma unroll
    for (int i = 0; i < 4; ++i) {
        const int rr = 8 * i + (lane >> 3), ch = lane & 7;
        const u32x4 v = *(const LAS u32x4*)(stg + rr * 144 + ch * 16);
        *(u32x4*)(Out + (rowbase + (long)dil * (qw0 + rr)) * pO + ch * 8) = v;
    }
    if (TYPE == 0) { if (hi == 0) A.LSE[((size_t)cfg * M + rowbase + (long)dil * (qw0 + r32)) * 8 + h] = mrun[0] + __log2f(ltot[0]); }
}
}

constexpr int ATT_UNITS = 640 + 1152;
__device__ __forceinline__ void attn_phase(LAS unsigned char* lds, const AttnBufs& A, unsigned* ctr) {
    volatile LAS int* sh = (volatile LAS int*)(lds + LDS_MISC);
    for (;;) {
        if (threadIdx.x == 0) *sh = (int)atomicAdd(ctr, 1u);
        __syncthreads();
        const int idx = __builtin_amdgcn_readfirstlane(*sh);
        __syncthreads();
        if (idx >= ATT_UNITS) break;
        if (idx < 640) {
            const int qb = 31 - idx / 20, j = idx % 20;
            if (j < 12) att::attn_unit<1>(lds, A, j / 6, j % 6, qb, 0, 0);
            else att::attn_unit<2>(lds, A, (j - 12) / 4, (j - 12) % 4, qb, 0, 0);
        } else {
            const int a = idx - 640, cfg = a / 384, rem = a % 384, b = rem / 192, h = (rem / 32) % 6, tile = rem % 32;
            const int dl = cfg == 0 ? 1 : (cfg == 1 ? 4 : 16);
            att::attn_unit<0>(lds, A, b, h, tile / dl, cfg, tile % dl);
        }
    }
}

__device__ __forceinline__ float wave_sum(float v) {
    v += swz<0x041f>(v); v += swz<0x081f>(v); v += swz<0x101f>(v); v += swz<0x201f>(v); v += swz<0x401f>(v);
    return xsum32(v);
}
__device__ __forceinline__ int src_col(int kind, int n) {
    if (kind == 0) {
        if (n < 768) { const int blk = n >> 6, p = n & 63; return (blk << 6) + ((p & 1) ? 32 + (p >> 1) : (p >> 1)); }
        if (n < 1664) return n;
        if (n < 1696) { const int p = n - 1664; return 1664 + ((p & 1) ? 16 + (p >> 1) : (p >> 1)); }
        if (n < 1792) return -1;
        if (n < 2304) { const int q = n - 1792, blk = q >> 5, p = q & 31; return 1696 + (blk << 5) + ((p & 1) ? 16 + (p >> 1) : (p >> 1)); }
        return n - 96;
    }
    if (kind == 1) { if (n >= 576) return -1; const int h = n / 96, p = n % 96; if (p < 64) return n; const int q = p - 64; return h * 96 + 64 + ((q & 1) ? 16 + (q >> 1) : (q >> 1)); }
    return n;
}
struct TItem { const float* W; const float* g; bf16_t* WT; int K, Nsrc, Ndst, kind, item; };
__device__ __forceinline__ void src_chunk(int kind, int n0, int c, int& scol, int& d0, int& dstep) {
    scol = -1; d0 = 4 * c; dstep = 1;
    if (kind == 0) {
        if (n0 < 768) { const int base = n0 & ~63, hb = (n0 >> 5) & 1;
            scol = base + (c < 4 ? 0 : 32) + 16 * hb + 4 * (c & 3); d0 = 8 * (c & 3) + (c < 4 ? 0 : 1); dstep = 2; return; }
        if (n0 < 1664) { scol = n0 + 4 * c; return; }
        if (n0 < 1696) { scol = 1664 + 4 * c; d0 = (c < 4) ? 8 * c : 8 * (c - 4) + 1; dstep = 2; return; }
        if (n0 < 1792) return;
        if (n0 < 2304) { scol = 1696 + (n0 - 1792) + 4 * c; d0 = (c < 4) ? 8 * c : 8 * (c - 4) + 1; dstep = 2; return; }
        scol = n0 - 96 + 4 * c; return;
    }
    if (kind == 1) {
        if (n0 >= 576) return;
        const int blk = (n0 >> 5) % 3;
        scol = n0 + 4 * c; if (blk == 2) { d0 = (c < 4) ? 8 * c : 8 * (c - 4) + 1; dstep = 2; }
        return;
    }
    scol = n0 + 4 * c;
}
__device__ __forceinline__ void titem_load(const TItem& t, int lane, f32x4 (&v)[8]) {
    const int nblk = t.Ndst / 32, kb = t.item / nblk, nb = t.item % nblk, k0 = 64 * kb, n0 = 32 * nb;
    int scol, d0, dstep; src_chunk(t.kind, n0, lane & 7, scol, d0, dstep);
#pragma unroll
    for (int i = 0; i < 8; ++i) { const int kk = 8 * i + (lane >> 3);
        f32x4 x = (f32x4){0.f, 0.f, 0.f, 0.f};
        if (scol >= 0) { x = *(const f32x4*)(t.W + (size_t)(k0 + kk) * t.Nsrc + scol); if (t.g) x = x * t.g[k0 + kk]; }
        v[i] = x; }
}
__device__ __forceinline__ void titem_finish(const TItem& t, int lane, const f32x4 (&v)[8], LAS float* scr) {
    const int nblk = t.Ndst / 32, kb = t.item / nblk, nb = t.item % nblk, k0 = 64 * kb, n0 = 32 * nb;
    int scol, d0, dstep; src_chunk(t.kind, n0, lane & 7, scol, d0, dstep);
#pragma unroll
    for (int i = 0; i < 8; ++i) { LAS float* r = scr + (8 * i + (lane >> 3)) * 33 + d0;
        r[0] = v[i][0]; r[dstep] = v[i][1]; r[2 * dstep] = v[i][2]; r[3 * dstep] = v[i][3]; }
    asm volatile("s_waitcnt lgkmcnt(0)" ::: "memory");
    const int c = lane & 7;
#pragma unroll
    for (int j = 0; j < 4; ++j) { const int n = (lane >> 3) + 8 * j; const LAS float* p = scr + (8 * c) * 33 + n;
        u32x4 o; o.x = pg8::cvt_pk_bf16(p[0 * 33], p[1 * 33]); o.y = pg8::cvt_pk_bf16(p[2 * 33], p[3 * 33]); o.z = pg8::cvt_pk_bf16(p[4 * 33], p[5 * 33]); o.w = pg8::cvt_pk_bf16(p[6 * 33], p[7 * 33]);
        *(u32x4*)(t.WT + (size_t)(n0 + n) * t.K + k0 + 8 * c) = o; }
    asm volatile("s_waitcnt lgkmcnt(0)" ::: "memory");
}

#define XB_TMO      128
#define XB_XCNT(j)  (256  + 64 * (j))
#define XB_XSUB(j)  (1280 + 64 * (j))
#define XB_XGEN(j)  (2304 + 64 * (j))
#define XB_TOP      3328
#define XB_TOPGEN   3392
#define XCD_BAR_WORDS 3456
#define XB_SPIN_CAP (1u << 18)

__device__ __forceinline__ unsigned xb_ld(unsigned* p)              { return __hip_atomic_load(p, __ATOMIC_RELAXED, __HIP_MEMORY_SCOPE_AGENT); }
__device__ __forceinline__ unsigned xb_add(unsigned* p, unsigned v) { return __hip_atomic_fetch_add(p, v, __ATOMIC_RELAXED, __HIP_MEMORY_SCOPE_AGENT); }
__device__ __forceinline__ unsigned xb_xcc_id() { return (unsigned)__builtin_amdgcn_s_getreg((3 << 11) | 20) & 0xFu; }
#define XB_SPIN(cond, bar) do { unsigned _sp = 0; while (cond) { __builtin_amdgcn_s_sleep(1); \
    if ((++_sp & 255u) == 0u) { if (xb_ld(&(bar)[XB_TMO])) break; if (_sp > XB_SPIN_CAP) { atomicAdd(&(bar)[XB_TMO], 1u); break; } } } } while (0)

struct XcdBarrier {
    unsigned* bar; unsigned x;
    volatile LAS unsigned* st;
};
__device__ __forceinline__ XcdBarrier xcd_barrier_post(unsigned* bar, volatile LAS unsigned* st) {
    XcdBarrier b; b.bar = bar; b.x = xb_xcc_id(); b.st = st;
    if (threadIdx.x == 0) (void)xb_add(&bar[XB_XCNT(b.x)], 1u);
    return b;
}
__device__ __forceinline__ void xcd_barrier_complete(unsigned* bar, unsigned x, unsigned& nloc, unsigned& nx) {
    const unsigned G = gridDim.x * gridDim.y * gridDim.z;
    unsigned sum, cnt, mine, sp = 0u;
    for (;;) {
        sum = 0u; cnt = 0u; mine = 0u;
#pragma unroll
        for (unsigned j = 0; j < 16; ++j) { const unsigned c = xb_ld(&bar[XB_XCNT(j)]); sum += c; cnt += (c > 0u) ? 1u : 0u; mine = (j == x) ? c : mine; }
        if (sum == G) break;
        __builtin_amdgcn_s_sleep(1);
        if ((++sp & 255u) == 0u) { if (xb_ld(&bar[XB_TMO])) break; if (sp > XB_SPIN_CAP) { atomicAdd(&bar[XB_TMO], 1u); break; } }
    }
    nloc = mine > 0u ? mine : 1u; nx = cnt > 0u ? cnt : 1u;
}

__device__ __forceinline__ void xcd_barrier(const XcdBarrier& b) {
    asm volatile("s_waitcnt vmcnt(0)" ::: "memory");
    __syncthreads();
    if (threadIdx.x == 0) {
        unsigned* bar = b.bar;
        __builtin_amdgcn_s_waitcnt(0);
        unsigned nloc = b.st[0], nx = b.st[1];
        if (nloc == 0u) { xcd_barrier_complete(bar, b.x, nloc, nx); b.st[0] = nloc; b.st[1] = nx; }
        const unsigned old = xb_add(&bar[XB_XSUB(b.x)], 1u);
        const unsigned gen = old / nloc;
        if (old + 1u == (gen + 1u) * nloc) {
            __builtin_amdgcn_fence(__ATOMIC_RELEASE, "agent");
            asm volatile("s_waitcnt vmcnt(0)" ::: "memory");
            const unsigned og = xb_add(&bar[XB_TOP], 1u);
            const unsigned tg = og / nx;
            if (og + 1u == (tg + 1u) * nx) xb_add(&bar[XB_TOPGEN], 1u);
            else XB_SPIN(xb_ld(&bar[XB_TOPGEN]) == tg, bar);
            __builtin_amdgcn_fence(__ATOMIC_ACQUIRE, "agent");
            xb_add(&bar[XB_XGEN(b.x)], 1u);
            asm volatile("s_waitcnt vmcnt(0)" ::: "memory");
        } else {
            XB_SPIN(xb_ld(&bar[XB_XGEN(b.x)]) == gen, bar);
            __builtin_amdgcn_fence(__ATOMIC_ACQUIRE, "agent");
            asm volatile("s_waitcnt vmcnt(0)" ::: "memory");
        }
    }
    __syncthreads();
}

struct Params { const float* in[14]; float* out; unsigned char* ws; float inv64[32]; float inv32[16]; };

__global__ void __launch_bounds__(512, 2) hybrid_fwd(Params p) {
    extern __shared__ __attribute__((aligned(16))) unsigned char lds_raw[];
    LAS unsigned char* lds = (LAS unsigned char*)lds_raw;
    cg::grid_group grid = cg::this_grid();
    if (threadIdx.x < 4) ((volatile LAS unsigned*)(lds + LDS_MISC + 64))[threadIdx.x] = 0u;
    __syncthreads();
    { XcdBarrier b0 = xcd_barrier_post((unsigned*)(p.ws + WS_CTL) + 1024, (volatile LAS unsigned*)(lds + LDS_MISC + 64)); (void)b0; }
#define GRID_BAR() do { XcdBarrier b_; b_.bar = (unsigned*)(p.ws + WS_CTL) + 1024; b_.x = xb_xcc_id(); b_.st = (volatile LAS unsigned*)(lds + LDS_MISC + 64); xcd_barrier(b_); } while (0)
#define WSP(name) size_t name##_off = 0; asm volatile("" : "+s"(name##_off)); unsigned char* name = p.ws + name##_off; int bx = blockIdx.x; asm volatile("" : "+s"(bx)); int G = gridDim.x; asm volatile("" : "+s"(G))
#define PTR(T, v, off) T* v = (T*)(ws + (off))
    grid.sync();
    {
        WSP(ws); const float* x = p.in[0];
        PTR(float, cos64, WS_COS64); PTR(float, sin64, WS_SIN64); PTR(float, cos32, WS_COS32); PTR(float, sin32, WS_SIN32); PTR(float, SS1, WS_SS1); PTR(float, LAM, WS_LAM); PTR(bf16_t, XB, WS_XB);
        int tid = threadIdx.x; asm volatile("" : "+v"(tid)); const int lane = tid & 63, wave = __builtin_amdgcn_readfirstlane(tid >> 6);
        LAS float* scr = (LAS float*)(lds + wave * 16384);
        const int gw = bx * 8 + wave, NGW = G * 8;
        constexpr int I_IN = 16 * 80, I_UQ = 6 * 24, I_UKV = 2 * 24, I_O = 16 * 32, I_UP = 16 * 128, I_DN = 64 * 32, I_L = I_IN + I_UQ + I_UKV + I_O + I_UP + I_DN;
#define TI_DECODE(t, it_) do { const int L_ = (it_) / I_L; int r_ = (it_) % I_L; unsigned char* wl_ = ws + WS_W + (size_t)L_ * W_LAYER; \
            if (r_ < I_IN) { t = TItem{p.in[2] + (size_t)L_ * 1024 * 2464, p.in[1] + L_ * 1024, (bf16_t*)(wl_ + W_IN), 1024, 2464, NIN, 0, r_}; break; } r_ -= I_IN; \
            if (r_ < I_UQ) { t = TItem{p.in[4] + (size_t)L_ * 384 * 576, p.in[3] + L_ * 384, (bf16_t*)(wl_ + W_UQ), 384, 576, 768, 1, r_}; break; } r_ -= I_UQ; \
            if (r_ < I_UKV) { t = TItem{p.in[6] + (size_t)L_ * 128 * 768, p.in[5] + L_ * 128, (bf16_t*)(wl_ + W_UKV), 128, 768, 768, 2, r_}; break; } r_ -= I_UKV; \
            if (r_ < I_O) { t = TItem{p.in[9] + (size_t)L_ * 1024 * 1024, nullptr, (bf16_t*)(wl_ + W_O), 1024, 1024, 1024, 2, r_}; break; } r_ -= I_O; \
            if (r_ < I_UP) { t = TItem{p.in[11] + (size_t)L_ * 1024 * 4096, p.in[10] + L_ * 1024, (bf16_t*)(wl_ + W_UP), 1024, 4096, 4096, 2, r_}; break; } r_ -= I_UP; \
            t = TItem{p.in[12] + (size_t)L_ * 4096 * 1024, nullptr, (bf16_t*)(wl_ + W_DN), 4096, 1024, 1024, 2, r_}; } while (0)
        for (int it = gw; it < 2 * I_L; it += 2 * NGW) {
            const bool two = it + NGW < 2 * I_L;
            TItem ta, tb; TI_DECODE(ta, it); TI_DECODE(tb, two ? it + NGW : it);
            f32x4 va[8], vb[8];
            titem_load(ta, lane, va); titem_load(tb, lane, vb);
            titem_finish(ta, lane, va, scr);
            if (two) titem_finish(tb, lane, vb, scr);
        }
#undef TI_DECODE
        for (int mrow = gw; mrow < M; mrow += 2 * NGW) {
            const int mrow2 = mrow + NGW;
            const f32x4* xr = (const f32x4*)(x + (size_t)mrow * DM) + lane; const f32x4* xr2 = (const f32x4*)(x + (size_t)mrow2 * DM) + lane;
            f32x4 v[4], w2[4];
#pragma unroll
            for (int j = 0; j < 4; ++j) { v[j] = xr[64 * j]; w2[j] = xr2[64 * j]; }
            float s = 0.f, s2 = 0.f;
#pragma unroll
            for (int j = 0; j < 4; ++j) {
                s += (v[j][0] * v[j][0] + v[j][1] * v[j][1]) + (v[j][2] * v[j][2] + v[j][3] * v[j][3]);
                s2 += (w2[j][0] * w2[j][0] + w2[j][1] * w2[j][1]) + (w2[j][2] * w2[j][2] + w2[j][3] * w2[j][3]);
                u32x2 w; w.x = pg8::cvt_pk_bf16(v[j][0], v[j][1]); w.y = pg8::cvt_pk_bf16(v[j][2], v[j][3]); *((u32x2*)(XB + (size_t)mrow * DM) + lane + 64 * j) = w;
                u32x2 u; u.x = pg8::cvt_pk_bf16(w2[j][0], w2[j][1]); u.y = pg8::cvt_pk_bf16(w2[j][2], w2[j][3]); *((u32x2*)(XB + (size_t)mrow2 * DM) + lane + 64 * j) = u; }
            s = wave_sum(s); s2 = wave_sum(s2);
            if (lane < 16) { SS1[(size_t)mrow * 16 + lane] = lane == 0 ? s : 0.f; SS1[(size_t)mrow2 * 16 + lane] = lane == 0 ? s2 : 0.f; }
        }
        const int gt = bx * 512 + tid, NGT = G * 512;
        for (int i = gt; i < SEQ * 48; i += NGT) {
            const int t = i / 48, j = i % 48;
            const float inv = j < 32 ? p.inv64[j] : p.inv32[j - 32];
            const float ang = (float)t * inv;
            double f = (double)ang * 0.15915494309189535; f -= __builtin_rint(f);
            const float ff = (float)f, c = __builtin_amdgcn_cosf(ff), s = __builtin_amdgcn_sinf(ff);
            if (j < 32) { cos64[t * 32 + j] = c; sin64[t * 32 + j] = s; } else { cos32[t * 16 + j - 32] = c; sin32[t * 16 + j - 32] = s; }
        }
        if (bx == 0 && tid < 2) {
            const float* lp = p.in[7] + tid * 128; float s1 = 0.f, s2 = 0.f;
            for (int i = 0; i < 32; ++i) { s1 += lp[i] * lp[32 + i]; s2 += lp[64 + i] * lp[96 + i]; }
            const float li = 0.8f - 0.6f * expf(-0.3f * (float)tid);
            LAM[tid * 2] = expf(s1) - expf(s2) + li; LAM[tid * 2 + 1] = 1.f - li;
        }
    }
    GRID_BAR();

    for (int L = 0; L < 2; ++L) {
        {
            WSP(ws); unsigned char* wl = ws + WS_W + (size_t)L * W_LAYER;
            PTR(float, cos64, WS_COS64); PTR(float, sin64, WS_SIN64); PTR(float, cos32, WS_COS32); PTR(float, sin32, WS_SIN32); PTR(float, SS1, WS_SS1); PTR(bf16_t, XB, WS_XB); PTR(bf16_t, Pb, WS_P);
            pg8::Gemm g{XB, (const bf16_t*)(wl + W_IN), M, 2048, 1024, 1024}; pg8::StaticOrder S; S.init(M, 2048, G, bx);
            EpiInProj E{Pb, cos64, sin64, cos32, sin32, 0}; TabSS T{SS1};
            pg8::gemm_phase<EpiInProj, pg8::StaticOrder, TabSS, true, true>(lds, g, S, E, T);
        }
        GRID_BAR();
        {
            const int Gh = (int)gridDim.x / 2;
            {
                WSP(ws); unsigned char* wl = ws + WS_W + (size_t)L * W_LAYER;
                PTR(float, cos64, WS_COS64); PTR(float, sin64, WS_SIN64); PTR(float, cos32, WS_COS32); PTR(float, sin32, WS_SIN32); PTR(float, SS1, WS_SS1); PTR(bf16_t, XB, WS_XB); PTR(bf16_t, Pb, WS_P);
                pg8::Gemm g{XB, (const bf16_t*)(wl + W_IN) + (size_t)2048 * 1024, M, 512, 1024, 1024}; pg8::StaticOrder S; S.init(M, 512, Gh, bx < Gh ? bx : (1 << 28));
                EpiInProj E{Pb, cos64, sin64, cos32, sin32, 8}; TabSS T{SS1};
                pg8::gemm_phase<EpiInProj, pg8::StaticOrder, TabSS, true, true>(lds, g, S, E, T);
            }
            {
                WSP(ws); unsigned char* wl = ws + WS_W + (size_t)L * W_LAYER; PTR(float, cos32, WS_COS32); PTR(float, sin32, WS_SIN32); PTR(bf16_t, Pb, WS_P); PTR(bf16_t, QB, WS_QB);
                pg8::Gemm g{Pb + 1152, (const bf16_t*)(wl + W_UQ), M, 768, 384, NIN}; pg8::StaticOrder S; S.init(M, 768, Gh, bx >= Gh ? bx - Gh : (1 << 28));
                EpiUq E{QB, cos32, sin32}; TabRows<384> T{Pb + 1152, NIN};
                pg8::gemm_phase<EpiUq, pg8::StaticOrder, TabRows<384>, true, true>(lds, g, S, E, T);
            }
            {
                WSP(ws); unsigned char* wl = ws + WS_W + (size_t)L * W_LAYER; PTR(bf16_t, Pb, WS_P); PTR(bf16_t, KVB, WS_KVB);
                pg8::Gemm g{Pb + 1536, (const bf16_t*)(wl + W_UKV), M, 768, 128, NIN}; pg8::StaticOrder S; S.init(M, 768, Gh, bx >= Gh ? (bx - Gh + Gh / 2) % Gh : (1 << 28));
                EpiScaled<0> E{KVB, 768}; TabRows<128> T{Pb + 1536, NIN};
                pg8::gemm_phase<EpiScaled<0>, pg8::StaticOrder, TabRows<128>, true, true>(lds, g, S, E, T);
            }
        }
        GRID_BAR();
        {
            WSP(ws); PTR(bf16_t, Pb, WS_P); PTR(bf16_t, QB, WS_QB); PTR(bf16_t, KVB, WS_KVB); PTR(bf16_t, OA, WS_OA); PTR(float, LSE, WS_LSE); PTR(bf16_t, MIX, WS_MIX); PTR(float, LAM, WS_LAM); PTR(unsigned, ctl, WS_CTL);
            AttnBufs A{Pb, QB, KVB, OA, LSE, MIX, p.in[8] + L * 64, LAM[L * 2], LAM[L * 2 + 1]};
            attn_phase(lds, A, ctl + 64 * L);
        }
        GRID_BAR();
        {
            WSP(ws); PTR(bf16_t, OA, WS_OA); PTR(float, LSE, WS_LSE); PTR(bf16_t, MIX, WS_MIX);
            int gt = bx * 512 + threadIdx.x; asm volatile("" : "+v"(gt)); const int NGT = G * 512;
            for (int it = gt; it < M * 48; it += NGT) {
                const int row = it / 48, j = it % 48, h = j >> 3, ch = j & 7;
                const float l0 = LSE[(size_t)row * 8 + h], l1 = LSE[((size_t)M + row) * 8 + h], l2 = LSE[((size_t)2 * M + row) * 8 + h];
                const float mx = fmaxf(l0, fmaxf(l1, l2));
                float w0 = __builtin_amdgcn_exp2f(l0 - mx), w1 = __builtin_amdgcn_exp2f(l1 - mx), w2 = __builtin_amdgcn_exp2f(l2 - mx);
                const float inv = 1.f / (w0 + w1 + w2); w0 *= inv; w1 *= inv; w2 *= inv;
                const size_t o = (size_t)row * 384 + h * 64 + ch * 8;
                const u32x4 a = *(const u32x4*)(OA + o), b = *(const u32x4*)(OA + (size_t)M * 384 + o), c = *(const u32x4*)(OA + (size_t)2 * M * 384 + o);
                f32x4 v0, v1;
                v0[0] = w0 * bf_lo(a.x) + w1 * bf_lo(b.x) + w2 * bf_lo(c.x); v0[1] = w0 * bf_hi(a.x) + w1 * bf_hi(b.x) + w2 * bf_hi(c.x);
                v0[2] = w0 * bf_lo(a.y) + w1 * bf_lo(b.y) + w2 * bf_lo(c.y); v0[3] = w0 * bf_hi(a.y) + w1 * bf_hi(b.y) + w2 * bf_hi(c.y);
                v1[0] = w0 * bf_lo(a.z) + w1 * bf_lo(b.z) + w2 * bf_lo(c.z); v1[1] = w0 * bf_hi(a.z) + w1 * bf_hi(b.z) + w2 * bf_hi(c.z);
                v1[2] = w0 * bf_lo(a.w) + w1 * bf_lo(b.w) + w2 * bf_lo(c.w); v1[3] = w0 * bf_hi(a.w) + w1 * bf_hi(b.w) + w2 * bf_hi(c.w);
                *(u32x4*)(MIX + (size_t)row * DM + h * 64 + ch * 8) = pack8(v0, v1);
            }
        }
        GRID_BAR();
        {
            WSP(ws); unsigned char* wl = ws + WS_W + (size_t)L * W_LAYER; PTR(bf16_t, MIX, WS_MIX); PTR(bf16_t, XB, WS_XB); PTR(float, SS2, WS_SS2); const float* x = p.in[0]; float* out = p.out;
            pg8::Gemm g{MIX, (const bf16_t*)(wl + W_O), M, 1024, 1024, 1024}; pg8::StaticOrder S; S.init(M, 1024, G, bx);
            EpiResid E{L == 0 ? x : (const float*)out, out, XB, SS2}; TabNone T;
            pg8::gemm_phase<EpiResid, pg8::StaticOrder, TabNone, true, true>(lds, g, S, E, T);
        }
        GRID_BAR();
        {
            WSP(ws); unsigned char* wl = ws + WS_W + (size_t)L * W_LAYER; PTR(bf16_t, XB, WS_XB); PTR(bf16_t, HB, WS_H); PTR(float, SS2, WS_SS2);
            pg8::Gemm g{XB, (const bf16_t*)(wl + W_UP), M, FF, 1024, 1024}; pg8::StaticOrder S; S.init(M, FF, G, bx);
            EpiScaled<1> E{HB, FF}; TabSS T{SS2};
            pg8::gemm_phase<EpiScaled<1>, pg8::StaticOrder, TabSS, true, true>(lds, g, S, E, T);
        }
        GRID_BAR();
        {
            WSP(ws); unsigned char* wl = ws + WS_W + (size_t)L * W_LAYER; PTR(bf16_t, XB, WS_XB); PTR(bf16_t, HB, WS_H); PTR(float, SS1, WS_SS1); float* out = p.out;
            pg8::Gemm g{HB, (const bf16_t*)(wl + W_DN), M, 1024, FF, FF}; pg8::StaticOrder S; S.init(M, 1024, G, bx);
            EpiResid E{out, out, XB, SS1}; TabNone T;
            pg8::gemm_phase<EpiResid, pg8::StaticOrder, TabNone, true, true>(lds, g, S, E, T);
        }
        GRID_BAR();
    }
    {
        WSP(ws); PTR(float, SS1, WS_SS1); float* out = p.out;
        int tidf = threadIdx.x; asm volatile("" : "+v"(tidf)); const int lane = tidf & 63;
        const int gw = bx * 8 + (tidf >> 6), NGW = G * 8;
        const float* fg = p.in[13];
        for (int mrow = gw; mrow < M; mrow += NGW) {
            float s = lane < 16 ? SS1[(size_t)mrow * 16 + lane] : 0.f;
            s = wave_sum(s);
            const float rs = 1.f / sqrtf(s * (1.f / 1024.f) + EPS);
            f32x4* xr = (f32x4*)(out + (size_t)mrow * DM) + lane;
#pragma unroll
            for (int j = 0; j < 4; ++j) { const f32x4 gg = *((const f32x4*)fg + lane + 64 * j); f32x4 v = xr[64 * j]; v = v * rs * gg; xr[64 * j] = v; }
        }
    }
}

extern "C" void kernel_launch(void* const* d_in, const int* in_sizes, int n_in, void* d_out, int out_size, void* d_ws, size_t ws_size, hipStream_t stream) {
    static int grid = 0;
    if (grid == 0) {
        if (n_in != 14 || ws_size < WS_END) { fprintf(stderr, "kernel_launch: unexpected n_in %d / ws_size %zu\n", n_in, ws_size); grid = -1; return; }
        int dev = 0, cus = 0, per_cu = 0;
        hipGetDevice(&dev); hipDeviceGetAttribute(&cus, hipDeviceAttributeMultiprocessorCount, dev);
        if (hipFuncSetAttribute((const void*)hybrid_fwd, hipFuncAttributeMaxDynamicSharedMemorySize, LDS_BYTES) != hipSuccess) { fprintf(stderr, "kernel_launch: hipFuncSetAttribute failed\n"); grid = -1; return; }
        hipOccupancyMaxActiveBlocksPerMultiprocessor(&per_cu, (const void*)hybrid_fwd, 512, LDS_BYTES);
        if (per_cu < 1) per_cu = 1;
        grid = cus * 1;
        fprintf(stderr, "kernel_launch: cus %d per_cu %d grid %d ws %zu\n", cus, per_cu, grid, ws_size);
        (void)hipGetLastError();
    }
    if (grid < 0) return;
    hipMemsetAsync((char*)d_ws + WS_CTL, 0, 32768, stream);
    Params p{};
    for (int i = 0; i < 14; ++i) p.in[i] = (const float*)d_in[i];
    p.out = (float*)d_out; p.ws = (unsigned char*)d_ws;
    for (int i = 0; i < 32; ++i) p.inv64[i] = 1.0f / powf(10000.0f, (float)i / 32.0f);
    for (int i = 0; i < 16; ++i) p.inv32[i] = 1.0f / powf(10000.0f, (float)i / 16.0f);
    void* args[] = {&p};
    hipError_t e = hipLaunchCooperativeKernel((const void*)hybrid_fwd, dim3(grid), dim3(512), args, LDS_BYTES, stream);
    if (e != hipSuccess) fprintf(stderr, "cooperative launch failed: %s (grid %d)\n", hipGetErrorString(e), grid);
}
```
